# Optimizing an MI355X kernel written in HIP

```python
import jax, jax.numpy as jnp
from jax import lax
import numpy as np

D_MODEL = 1024
BATCH = 32
SEQ = 2048
DEPTH = 1

D_CONV = D_MODEL
CONV_WIDTH = 3
HEAD_DIM = 64
N_HEADS = D_MODEL // HEAD_DIM
N_KV_HEADS = 2
GROUP = N_HEADS // N_KV_HEADS
D_ATTN = N_HEADS * HEAD_DIM
D_KV = N_KV_HEADS * HEAD_DIM
WINDOW = 128
BLOCK = WINDOW
ROPE_THETA = 10000.0
RMS_EPS = 1e-6
SPLITS = (D_CONV, D_CONV, D_CONV, D_CONV, D_ATTN, D_KV, D_KV, D_ATTN, D_MODEL, D_MODEL)
D_IN = int(sum(SPLITS))
SPLIT_IDX = [int(s) for s in np.cumsum(SPLITS)[:-1]]

kernel_name = "hybrid_shortconv_swa_sink_gated_merge"


def rmsnorm(x, g):
    xf = x.astype(jnp.float32)
    y = xf * lax.rsqrt(jnp.mean(xf * xf, axis=-1, keepdims=True) + RMS_EPS)
    return (y * g.astype(jnp.float32)).astype(x.dtype)


def short_gated_conv(xc, bg, cg, w_conv):
    u = cg * xc
    t = u.shape[1]
    u_pad = jnp.pad(u, ((0, 0), (CONV_WIDTH - 1, 0), (0, 0)))
    y = w_conv[0] * u_pad[:, 0:t]
    for tap in range(1, CONV_WIDTH):
        y = y + w_conv[tap] * u_pad[:, tap:tap + t]
    return bg * y


def rope(z, positions):
    inv_freq = ROPE_THETA ** (-jnp.arange(0, HEAD_DIM, 2, dtype=jnp.float32) / HEAD_DIM)
    ang = positions.astype(jnp.float32)[:, None] * inv_freq[None, :]
    cos = jnp.cos(ang)[:, None, :]
    sin = jnp.sin(ang)[:, None, :]
    zf = z.astype(jnp.float32)
    z1, z2 = zf[..., :HEAD_DIM // 2], zf[..., HEAD_DIM // 2:]
    out = jnp.concatenate([z1 * cos - z2 * sin, z2 * cos + z1 * sin], axis=-1)
    return out.astype(z.dtype)


def sliding_window_attention(q, k, v, sinks):
    b, t = q.shape[0], q.shape[1]
    nblk = t // BLOCK
    qb = q.reshape(b, nblk, BLOCK, N_KV_HEADS, GROUP, HEAD_DIM).transpose(1, 0, 2, 3, 4, 5)

    def band(z):
        zb = z.reshape(b, nblk, BLOCK, N_KV_HEADS, HEAD_DIM)
        prev = jnp.concatenate([jnp.zeros_like(zb[:, :1]), zb[:, :-1]], axis=1)
        return jnp.concatenate([prev, zb], axis=2).transpose(1, 0, 2, 3, 4)

    kb, vb = band(k), band(v)
    qi = jnp.arange(BLOCK)[:, None]
    kj = jnp.arange(2 * BLOCK)[None, :]
    in_band = (kj > qi) & (kj <= qi + BLOCK)
    sink = sinks.astype(jnp.float32).reshape(N_KV_HEADS, GROUP, 1, 1)
    scale = HEAD_DIM ** -0.5

    def one_block(args):
        blk, qblk, kblk, vblk = args
        logits = jnp.einsum('bqkgd,bskd->bkgqs', qblk, kblk).astype(jnp.float32) * scale
        valid = in_band & (kj >= BLOCK - blk * BLOCK)
        logits = jnp.where(valid, logits, -jnp.inf)
        m = jnp.maximum(jnp.max(logits, axis=-1, keepdims=True), sink)
        p = jnp.exp(logits - m)
        denom = jnp.sum(p, axis=-1, keepdims=True) + jnp.exp(sink - m)
        probs = (p / denom).astype(vblk.dtype)
        return jnp.einsum('bkgqs,bskd->bqkgd', probs, vblk)

    out = lax.map(one_block, (jnp.arange(nblk), qb, kb, vb))
    return out.transpose(1, 0, 2, 3, 4, 5).reshape(b, t, D_ATTN)


def hybrid_layer(x, g_pre, g_post, w_in, w_conv, sinks, w_proj_conv, w_proj_attn, w_out):
    b, t, _ = x.shape
    h = rmsnorm(x, g_pre)
    proj = jnp.einsum('btd,de->bte', h, w_in)
    xc, bg, cg, zc, q, k, v, za, ga, gb = jnp.split(proj, SPLIT_IDX, axis=-1)

    ua = jax.nn.silu(zc) * short_gated_conv(xc, bg, cg, w_conv)
    ya = jnp.einsum('btc,cd->btd', ua, w_proj_conv)

    positions = jnp.arange(t)
    q = rope(q.reshape(b, t, N_HEADS, HEAD_DIM), positions)
    k = rope(k.reshape(b, t, N_KV_HEADS, HEAD_DIM), positions)
    v = v.reshape(b, t, N_KV_HEADS, HEAD_DIM)
    ub = jax.nn.silu(za) * sliding_window_attention(q, k, v, sinks)
    yb = jnp.einsum('bta,ad->btd', ub, w_proj_attn)

    merged = jax.nn.sigmoid(ga) * ya + jax.nn.sigmoid(gb) * yb
    y = jnp.einsum('btd,de->bte', merged, w_out)
    return x + rmsnorm(y, g_post)


def setup_inputs(seed: int = 0) -> dict:
    key = jax.random.key(seed)
    ks = jax.random.split(key, 10)
    f32 = jnp.float32
    x = jax.random.normal(ks[0], (BATCH, SEQ, D_MODEL), f32)
    g_pre = 1.0 + 0.05 * jax.random.normal(ks[1], (DEPTH, D_MODEL), f32)
    g_post = 1.0 + 0.05 * jax.random.normal(ks[2], (DEPTH, D_MODEL), f32)
    w_in = jax.random.normal(ks[3], (DEPTH, D_MODEL, D_IN), f32) * D_MODEL ** -0.5
    w_conv = jax.random.normal(ks[4], (DEPTH, CONV_WIDTH, D_CONV), f32) * CONV_WIDTH ** -0.5
    sinks = 0.5 * jax.random.normal(ks[5], (DEPTH, N_HEADS), f32)
    w_proj_conv = jax.random.normal(ks[6], (DEPTH, D_CONV, D_MODEL), f32) * D_CONV ** -0.5
    w_proj_attn = jax.random.normal(ks[7], (DEPTH, D_ATTN, D_MODEL), f32) * D_ATTN ** -0.5
    w_out = jax.random.normal(ks[8], (DEPTH, D_MODEL, D_MODEL), f32) * D_MODEL ** -0.5
    return {"x": x, "g_pre": g_pre, "g_post": g_post, "w_in": w_in, "w_conv": w_conv,
            "sinks": sinks, "w_proj_conv": w_proj_conv, "w_proj_attn": w_proj_attn, "w_out": w_out}


def reference(x, g_pre, g_post, w_in, w_conv, sinks, w_proj_conv, w_proj_attn, w_out):
    for layer in range(DEPTH):
        x = hybrid_layer(x, g_pre[layer], g_post[layer], w_in[layer], w_conv[layer], sinks[layer],
                         w_proj_conv[layer], w_proj_attn[layer], w_out[layer])
    return x
```

```cpp
#include <hip/hip_runtime.h>
#include <cstdio>
#include <cstdint>

typedef unsigned short bf16_t;
typedef short bf16x8 __attribute__((ext_vector_type(8)));
typedef float f32x16 __attribute__((ext_vector_type(16)));
typedef float f32x4 __attribute__((ext_vector_type(4)));

constexpr int BATCH = 32, SEQ = 2048, D = 1024, M = BATCH * SEQ;
constexpr int NHEAD = 16, HD = 64, NKV = 2, GROUP = 8, WINDOW = 128;
constexpr int DIN = 8448, NT1 = DIN / 256;
constexpr int O_XC = 0, O_BG = 1024, O_CG = 2048, O_ZC = 3072, O_Q = 4096, O_K = 5120, O_V = 5248, O_ZA = 5376, O_GA = 6400, O_GB = 7424;
constexpr float RMS_EPS = 1e-6f;
constexpr float LOG2E = 1.4426950408889634f;
constexpr float QSCALE = 0.125f * LOG2E;

constexpr size_t MiB = 1u << 20;
constexpr size_t WS_CTL = 0;
constexpr size_t WS_WIN_T = 1 * MiB;
constexpr size_t WS_WCAT_T = 18 * MiB;
constexpr size_t WS_WO_T = 22 * MiB;
constexpr size_t WS_ROPE = 24 * MiB;
constexpr size_t WS_XCH = 25 * MiB;
constexpr size_t WS_XN = 32 * MiB;
constexpr size_t WS_U = 160 * MiB;
constexpr size_t WS_G = 288 * MiB;
constexpr size_t WS_Q = 416 * MiB;
constexpr size_t WS_ZA = 544 * MiB;
constexpr size_t WS_R = 672 * MiB;
constexpr size_t WS_SB = 800 * MiB;
constexpr size_t WS_KV = 928 * MiB;
constexpr size_t WS_END = 960 * MiB;

__host__ __device__ __forceinline__ unsigned f2bf(float f) { unsigned u = __builtin_bit_cast(unsigned, f); return (u + 0x7fffu + ((u >> 16) & 1u)) >> 16; }
__host__ __device__ __forceinline__ float bf2f(unsigned b) { return __builtin_bit_cast(float, (b & 0xffffu) << 16); }

__host__ __device__ __forceinline__ int win_src_col(int pn, int j) {
    if (pn < 16) { const int c0 = 64 * pn; return j < 64 ? O_XC + c0 + j : j < 128 ? O_BG + c0 + (j - 64) : j < 192 ? O_CG + c0 + (j - 128) : O_ZC + c0 + (j - 192); }
    if (pn < 20) { const int hf = j >> 7, jj = j & 127, hh = jj >> 5, d = (jj & 31) + 32 * hf; return O_Q + (4 * (pn - 16) + hh) * 64 + d; }
    if (pn == 20) { const int hf = j >> 7, jj = j & 127;
        if (jj < 64) { const int hh = jj >> 5, d = (jj & 31) + 32 * hf; return O_K + hh * 64 + d; }
        return O_V + hf * 64 + (jj - 64); }
    if (pn < 25) return O_ZA + 256 * (pn - 21) + j;
    { const int c0 = 128 * (pn - 25); return j < 128 ? O_GA + c0 + j : O_GB + c0 + (j - 128); }
}

struct Ptrs {
    const float *x, *g_pre, *g_post, *w_in, *w_conv, *sinks, *w_pc, *w_pa, *w_out;
    float* out; unsigned char* ws;
};

__device__ __forceinline__ float sigmoidf_(float v) { return 1.f / (1.f + __expf(-v)); }

__device__ __forceinline__ void epi_pair(unsigned char* ws, int pn, int r, int j, float v0, float v1) {
    bf16_t* U = (bf16_t*)(ws + WS_U); bf16_t* G = (bf16_t*)(ws + WS_G); bf16_t* Q = (bf16_t*)(ws + WS_Q); bf16_t* ZA = (bf16_t*)(ws + WS_ZA);
    bf16_t* R = (bf16_t*)(ws + WS_R); bf16_t* SB = (bf16_t*)(ws + WS_SB); bf16_t* KV = (bf16_t*)(ws + WS_KV);
    const float* rc = (const float*)(ws + WS_ROPE); const float* rs = rc + SEQ * 32;
    if (pn < 16) {
        const int c0 = 64 * pn;
        if (j < 64) U[(size_t)r * D + c0 + j] = (bf16_t)f2bf(v1 * v0);
        else        G[(size_t)r * D + c0 + (j - 64)] = (bf16_t)f2bf(v1 * sigmoidf_(v1) * v0);
    } else if (pn < 20) {
        const int hh = j >> 5, d = j & 31, head = 4 * (pn - 16) + hh, pos = r & (SEQ - 1);
        const float c = rc[pos * 32 + d], s = rs[pos * 32 + d];
        Q[(size_t)r * D + head * 64 + d] = (bf16_t)f2bf((v0 * c - v1 * s) * QSCALE);
        Q[(size_t)r * D + head * 64 + 32 + d] = (bf16_t)f2bf((v1 * c + v0 * s) * QSCALE);
    } else if (pn == 20) {
        if (j < 64) { const int hh = j >> 5, d = j & 31, pos = r & (SEQ - 1); const float c = rc[pos * 32 + d], s = rs[pos * 32 + d];
            KV[(size_t)r * 256 + hh * 64 + d] = (bf16_t)f2bf(v0 * c - v1 * s); KV[(size_t)r * 256 + hh * 64 + 32 + d] = (bf16_t)f2bf(v1 * c + v0 * s); }
        else { KV[(size_t)r * 256 + 128 + (j - 64)] = (bf16_t)f2bf(v0); KV[(size_t)r * 256 + 192 + (j - 64)] = (bf16_t)f2bf(v1); }
    } else if (pn < 25) {
        const int c = 256 * (pn - 21) + j;
        ZA[(size_t)r * D + c] = (bf16_t)f2bf(v0 * sigmoidf_(v0)); ZA[(size_t)r * D + c + 128] = (bf16_t)f2bf(v1 * sigmoidf_(v1));
    } else {
        const int c = 128 * (pn - 25) + j;
        const float ga = fminf(fmaxf(v0, -60.f), 60.f), gb = fminf(fmaxf(v1, -60.f), 60.f);
        const float ea = __expf(-ga), eb = __expf(-gb);
        SB[(size_t)r * D + c] = (bf16_t)f2bf(1.f / (1.f + eb));
        R[(size_t)r * D + c] = (bf16_t)f2bf((1.f + eb) / (1.f + ea));
    }
}

namespace nv {
__global__ void prep_weights(Ptrs p) {
    const size_t tid = (size_t)blockIdx.x * blockDim.x + threadIdx.x, nth = (size_t)gridDim.x * blockDim.x;
    bf16_t* win_t = (bf16_t*)(p.ws + WS_WIN_T); bf16_t* wcat_t = (bf16_t*)(p.ws + WS_WCAT_T); bf16_t* wo_t = (bf16_t*)(p.ws + WS_WO_T);
    for (size_t i = tid; i < (size_t)DIN * D; i += nth) { const int n = (int)(i / D), k = (int)(i % D); win_t[i] = (bf16_t)f2bf(p.w_in[(size_t)k * DIN + win_src_col(n >> 8, n & 255)]); }
    for (size_t i = tid; i < (size_t)D * 2 * D; i += nth) { const int n = (int)(i / (2 * D)), k = (int)(i % (2 * D)); wcat_t[i] = (bf16_t)f2bf(k < D ? p.w_pc[(size_t)k * D + n] : p.w_pa[(size_t)(k - D) * D + n]); }
    for (size_t i = tid; i < (size_t)D * D; i += nth) { const int n = (int)(i / D), k = (int)(i % D); wo_t[i] = (bf16_t)f2bf(p.w_out[(size_t)k * D + n]); }
    float* rc = (float*)(p.ws + WS_ROPE); float* rs = rc + SEQ * 32;
    for (size_t i = tid; i < (size_t)SEQ * 32; i += nth) { const int pos = (int)(i / 32), d = (int)(i % 32);
        const float inv = (float)pow(10000.0, -(double)d / 32.0); const float ang = (float)pos * inv;
        rc[i] = (float)cos((double)ang); rs[i] = (float)sin((double)ang); }
}
__global__ void prep_xn(Ptrs p) {
    const int lane = threadIdx.x & 63; const int row = blockIdx.x * (blockDim.x >> 6) + (threadIdx.x >> 6);
    const f32x4* xr = (const f32x4*)(p.x + (size_t)row * D) + lane; const f32x4* gr = (const f32x4*)p.g_pre + lane;
    f32x4 v[4]; float s = 0.f;
#pragma unroll
    for (int j = 0; j < 4; ++j) { v[j] = xr[64 * j]; s += (v[j].x * v[j].x + v[j].y * v[j].y) + (v[j].z * v[j].z + v[j].w * v[j].w); }
#pragma unroll
    for (int o = 1; o < 64; o <<= 1) s += __shfl_xor(s, o);
    const float rstd = 1.f / sqrtf(s * (1.f / D) + RMS_EPS);
    unsigned long long* o8 = (unsigned long long*)((bf16_t*)(p.ws + WS_XN) + (size_t)row * D) + lane;
#pragma unroll
    for (int j = 0; j < 4; ++j) { const f32x4 g = gr[64 * j];
        const unsigned lo = f2bf(v[j].x * rstd * g.x) | (f2bf(v[j].y * rstd * g.y) << 16), hi = f2bf(v[j].z * rstd * g.z) | (f2bf(v[j].w * rstd * g.w) << 16);
        o8[64 * j] = (unsigned long long)lo | ((unsigned long long)hi << 32); }
}
__device__ __forceinline__ void tile32(const bf16_t* A, int lda, const bf16_t* Bt, int ldb, int K, int row0, int col0, f32x16& acc, int lane) {
    const int r = lane & 31, h = lane >> 5;
    const bf16_t* ap = A + (size_t)(row0 + r) * lda + 8 * h; const bf16_t* bp = Bt + (size_t)(col0 + r) * ldb + 8 * h;
    for (int k = 0; k < K; k += 16) { const bf16x8 a = *(const bf16x8*)(ap + k), b = *(const bf16x8*)(bp + k); acc = __builtin_amdgcn_mfma_f32_32x32x16_bf16(a, b, acc, 0, 0, 0); }
}
__device__ __forceinline__ int crow(int reg, int h) { return (reg & 3) + 8 * (reg >> 2) + 4 * h; }
__global__ void gemm1(Ptrs p) {
    const int lane = threadIdx.x & 63, w = threadIdx.x >> 6; const int pn = blockIdx.x % NT1, row0 = (blockIdx.x / NT1) * 32, j0 = 32 * w;
    const bf16_t* A = (const bf16_t*)(p.ws + WS_XN); const bf16_t* Bt = (const bf16_t*)(p.ws + WS_WIN_T);
    f32x16 a0 = {}, a1 = {};
    tile32(A, D, Bt, D, D, row0, pn * 256 + j0, a0, lane); tile32(A, D, Bt, D, D, row0, pn * 256 + 128 + j0, a1, lane);
    const int h = lane >> 5, c = lane & 31;
#pragma unroll
    for (int r = 0; r < 16; ++r) epi_pair(p.ws, pn, row0 + crow(r, h), j0 + c, a0[r], a1[r]);
}
__global__ void conv(Ptrs p) {
    const size_t i = (size_t)blockIdx.x * blockDim.x + threadIdx.x; const int r = (int)(i / D), c = (int)(i % D), t = r & (SEQ - 1);
    const bf16_t* U = (const bf16_t*)(p.ws + WS_U); bf16_t* G = (bf16_t*)(p.ws + WS_G);
    const float w0 = p.w_conv[c], w1 = p.w_conv[D + c], w2 = p.w_conv[2 * D + c];
    float y = w2 * bf2f(U[i]); if (t >= 1) y += w1 * bf2f(U[i - D]); if (t >= 2) y += w0 * bf2f(U[i - 2 * D]);
    G[i] = (bf16_t)f2bf(bf2f(G[i]) * y);
}
__global__ void attn(Ptrs p) {
    const int lane = threadIdx.x & 63; const size_t wv = (size_t)blockIdx.x * (blockDim.x >> 6) + (threadIdx.x >> 6);
    const int r = (int)(wv / NHEAD), h = (int)(wv % NHEAD), t = r & (SEQ - 1), kh = h / GROUP;
    bf16_t* Q = (bf16_t*)(p.ws + WS_Q); const bf16_t* KV = (const bf16_t*)(p.ws + WS_KV); const bf16_t* ZA = (const bf16_t*)(p.ws + WS_ZA);
    const float qd = bf2f(Q[(size_t)r * D + h * 64 + lane]);
    float l0 = 0.f, l1 = 0.f;
    for (int d = 0; d < 64; ++d) { const float q = __shfl(qd, d);
        if (t - lane >= 0) l0 += q * bf2f(KV[(size_t)(r - lane) * 256 + kh * 64 + d]);
        if (t - 64 - lane >= 0) l1 += q * bf2f(KV[(size_t)(r - 64 - lane) * 256 + kh * 64 + d]); }
    if (t - lane < 0) l0 = -INFINITY; if (t - 64 - lane < 0) l1 = -INFINITY;
    const float sk = p.sinks[h] * LOG2E;
    float m = fmaxf(fmaxf(l0, l1), sk);
#pragma unroll
    for (int o = 1; o < 64; o <<= 1) m = fmaxf(m, __shfl_xor(m, o));
    const float p0 = exp2f(l0 - m), p1 = exp2f(l1 - m);
    float s = p0 + p1;
#pragma unroll
    for (int o = 1; o < 64; o <<= 1) s += __shfl_xor(s, o);
    s += exp2f(sk - m);
    float o = 0.f;
    for (int kk = 0; kk < 64; ++kk) { const float a = __shfl(p0, kk), b = __shfl(p1, kk);
        if (t - kk >= 0) o += a * bf2f(KV[(size_t)(r - kk) * 256 + 128 + kh * 64 + lane]);
        if (t - 64 - kk >= 0) o += b * bf2f(KV[(size_t)(r - 64 - kk) * 256 + 128 + kh * 64 + lane]); }
    o /= s;
    Q[(size_t)r * D + h * 64 + lane] = (bf16_t)f2bf(bf2f(ZA[(size_t)r * D + h * 64 + lane]) * o);
}
__global__ void gemm_merge(Ptrs p) {
    const int lane = threadIdx.x & 63; const size_t wv = (size_t)blockIdx.x * (blockDim.x >> 6) + (threadIdx.x >> 6);
    const int row0 = (int)(wv / 32) * 32, col0 = (int)(wv % 32) * 32;
    const bf16_t* UA = (const bf16_t*)(p.ws + WS_G); const bf16_t* UB = (const bf16_t*)(p.ws + WS_Q); const bf16_t* Wc = (const bf16_t*)(p.ws + WS_WCAT_T);
    const bf16_t* R = (const bf16_t*)(p.ws + WS_R); const bf16_t* SB = (const bf16_t*)(p.ws + WS_SB); bf16_t* MG = (bf16_t*)(p.ws + WS_XN);
    f32x16 acc = {};
    tile32(UA, D, Wc, 2 * D, D, row0, col0, acc, lane);
    const int h = lane >> 5, c = col0 + (lane & 31);
#pragma unroll
    for (int r = 0; r < 16; ++r) acc[r] *= bf2f(R[(size_t)(row0 + crow(r, h)) * D + c]);
    tile32(UB, D, Wc + D, 2 * D, D, row0, col0, acc, lane);
#pragma unroll
    for (int r = 0; r < 16; ++r) { const size_t o = (size_t)(row0 + crow(r, h)) * D + c; MG[o] = (bf16_t)f2bf(acc[r] * bf2f(SB[o])); }
}
__global__ void gemm_out(Ptrs p) {
    const int lane = threadIdx.x & 63; const size_t wv = (size_t)blockIdx.x * (blockDim.x >> 6) + (threadIdx.x >> 6);
    const int row0 = (int)(wv / 32) * 32, col0 = (int)(wv % 32) * 32;
    f32x16 acc = {};
    tile32((const bf16_t*)(p.ws + WS_XN), D, (const bf16_t*)(p.ws + WS_WO_T), D, D, row0, col0, acc, lane);
    const int h = lane >> 5, c = col0 + (lane & 31);
#pragma unroll
    for (int r = 0; r < 16; ++r) p.out[(size_t)(row0 + crow(r, h)) * D + c] = acc[r];
}
__global__ void finalize(Ptrs p) {
    const int lane = threadIdx.x & 63; const int row = blockIdx.x * (blockDim.x >> 6) + (threadIdx.x >> 6);
    f32x4* yr = (f32x4*)(p.out + (size_t)row * D) + lane; const f32x4* xr = (const f32x4*)(p.x + (size_t)row * D) + lane; const f32x4* gr = (const f32x4*)p.g_post + lane;
    f32x4 v[4]; float s = 0.f;
#pragma unroll
    for (int j = 0; j < 4; ++j) { v[j] = yr[64 * j]; s += (v[j].x * v[j].x + v[j].y * v[j].y) + (v[j].z * v[j].z + v[j].w * v[j].w); }
#pragma unroll
    for (int o = 1; o < 64; o <<= 1) s += __shfl_xor(s, o);
    const float rstd = 1.f / sqrtf(s * (1.f / D) + RMS_EPS);
#pragma unroll
    for (int j = 0; j < 4; ++j) yr[64 * j] = xr[64 * j] + v[j] * rstd * gr[64 * j];
}
}

extern "C" void kernel_launch(void* const* d_in, const int* in_sizes, int n_in, void* d_out, int out_size, void* d_ws, size_t ws_size, hipStream_t stream) {
    if (n_in != 9 || in_sizes[0] != M * D || out_size != M * D || ws_size < WS_END) { fprintf(stderr, "kernel_launch: unexpected shapes (n_in %d, in0 %d, out %d, ws %zu)\n", n_in, n_in > 0 ? in_sizes[0] : -1, out_size, ws_size); return; }
    Ptrs p{};
    p.x = (const float*)d_in[0]; p.g_pre = (const float*)d_in[1]; p.g_post = (const float*)d_in[2]; p.w_in = (const float*)d_in[3]; p.w_conv = (const float*)d_in[4];
    p.sinks = (const float*)d_in[5]; p.w_pc = (const float*)d_in[6]; p.w_pa = (const float*)d_in[7]; p.w_out = (const float*)d_in[8]; p.out = (float*)d_out; p.ws = (unsigned char*)d_ws;
    hipLaunchKernelGGL(nv::prep_weights, dim3(2048), dim3(256), 0, stream, p);
    hipLaunchKernelGGL(nv::prep_xn, dim3(M / 4), dim3(256), 0, stream, p);
    hipLaunchKernelGGL(nv::gemm1, dim3((M / 32) * NT1), dim3(256), 0, stream, p);
    hipLaunchKernelGGL(nv::conv, dim3((unsigned)((size_t)M * D / 256)), dim3(256), 0, stream, p);
    hipLaunchKernelGGL(nv::attn, dim3((unsigned)((size_t)M * NHEAD / 4)), dim3(256), 0, stream, p);
    hipLaunchKernelGGL(nv::gemm_merge, dim3((M / 32) * 32 / 4), dim3(256), 0, stream, p);
    hipLaunchKernelGGL(nv::gemm_out, dim3((M / 32) * 32 / 4), dim3(256), 0, stream, p);
    hipLaunchKernelGGL(nv::finalize, dim3(M / 4), dim3(256), 0, stream, p);
}
```

```cpp
#include <hip/hip_runtime.h>
#include <hip/hip_cooperative_groups.h>
#include <cstdio>
#include <cstdint>
namespace cg = cooperative_groups;

#ifndef MK_N_LAUNCHES
#define MK_N_LAUNCHES 1
#endif
#ifndef MK_NAIVE_MASK
#define MK_NAIVE_MASK 0
#endif

#ifndef MK_PHASE_MASK
#define MK_PHASE_MASK 63
#endif

typedef unsigned short bf16_t;
typedef short bf16x8 __attribute__((ext_vector_type(8)));
typedef float f32x16 __attribute__((ext_vector_type(16)));
typedef float f32x4 __attribute__((ext_vector_type(4)));
typedef float f32x2 __attribute__((ext_vector_type(2)));
typedef unsigned u32x4 __attribute__((ext_vector_type(4)));
typedef unsigned u32x2 __attribute__((ext_vector_type(2)));
typedef __bf16 bf16x2_t __attribute__((ext_vector_type(2)));

constexpr int BATCH = 32, SEQ = 2048, D = 1024, M = BATCH * SEQ;
constexpr int NHEAD = 16, HD = 64, NKV = 2, GROUP = 8, WINDOW = 128;
constexpr int DIN = 8448, NT1 = DIN / 256;
constexpr int O_XC = 0, O_BG = 1024, O_CG = 2048, O_ZC = 3072, O_Q = 4096, O_K = 5120, O_V = 5248, O_ZA = 5376, O_GA = 6400, O_GB = 7424;
constexpr float RMS_EPS = 1e-6f;
constexpr float LOG2E = 1.4426950408889634f;
constexpr float QSCALE = 0.125f * LOG2E;

constexpr size_t MiB = 1u << 20;
constexpr size_t WS_CTL = 0, CTL_ZERO_BYTES = 1 * MiB;
constexpr size_t WS_WIN_T = 1 * MiB;
constexpr size_t WS_WCAT_T = 18 * MiB;
constexpr size_t WS_WO_T = 22 * MiB;
constexpr size_t WS_ROPE = 24 * MiB;
constexpr size_t WS_XCH = 25 * MiB;
constexpr size_t WS_XN = 32 * MiB;
constexpr size_t WS_U = 160 * MiB;
constexpr size_t WS_G = 288 * MiB;
constexpr size_t WS_Q = 416 * MiB;
constexpr size_t WS_ZA = 544 * MiB;
constexpr size_t WS_R = 672 * MiB;
constexpr size_t WS_SB = 800 * MiB;
constexpr size_t WS_KV = 928 * MiB;
constexpr size_t WS_END = 960 * MiB;
constexpr int CW_BAR = 4096;
constexpr int CW_SEAM = 16384;

__host__ __device__ __forceinline__ unsigned f2bf(float f) { unsigned u = __builtin_bit_cast(unsigned, f); return (u + 0x7fffu + ((u >> 16) & 1u)) >> 16; }
__host__ __device__ __forceinline__ float bf2f(unsigned b) { return __builtin_bit_cast(float, (b & 0xffffu) << 16); }
__device__ __forceinline__ unsigned cvtpk(float lo, float hi) { f32x2 v = {lo, hi}; bf16x2_t b = __builtin_convertvector(v, bf16x2_t); return __builtin_bit_cast(unsigned, b); }
__device__ __forceinline__ float bflo(unsigned w) { return __builtin_bit_cast(float, w << 16); }
__device__ __forceinline__ float bfhi(unsigned w) { return __builtin_bit_cast(float, w & 0xffff0000u); }

__host__ __device__ __forceinline__ int win_src_col(int pn, int j) {
    if (pn < 16) { const int c0 = 64 * pn; return j < 64 ? O_XC + c0 + j : j < 128 ? O_BG + c0 + (j - 64) : j < 192 ? O_CG + c0 + (j - 128) : O_ZC + c0 + (j - 192); }
    if (pn < 20) { const int hf = j >> 7, jj = j & 127, hh = jj >> 5, d = (jj & 31) + 32 * hf; return O_Q + (4 * (pn - 16) + hh) * 64 + d; }
    if (pn == 20) { const int hf = j >> 7, jj = j & 127;
        if (jj < 64) { const int hh = jj >> 5, d = (jj & 31) + 32 * hf; return O_K + hh * 64 + d; }
        return O_V + hf * 64 + (jj - 64); }
    if (pn < 25) return O_ZA + 256 * (pn - 21) + j;
    { const int c0 = 128 * (pn - 25); return j < 128 ? O_GA + c0 + j : O_GB + c0 + (j - 128); }
}

struct Ptrs {
    const float *x, *g_pre, *g_post, *w_in, *w_conv, *sinks, *w_pc, *w_pa, *w_out;
    float* out; unsigned char* ws;
};

__device__ __forceinline__ float sigmoidf_(float v) { return 1.f / (1.f + __expf(-v)); }

__device__ __forceinline__ void epi_pair(unsigned char* ws, int pn, int r, int j, float v0, float v1) {
    bf16_t* U = (bf16_t*)(ws + WS_U); bf16_t* G = (bf16_t*)(ws + WS_G); bf16_t* Q = (bf16_t*)(ws + WS_Q); bf16_t* ZA = (bf16_t*)(ws + WS_ZA);
    bf16_t* R = (bf16_t*)(ws + WS_R); bf16_t* SB = (bf16_t*)(ws + WS_SB); bf16_t* KV = (bf16_t*)(ws + WS_KV);
    const float* rc = (const float*)(ws + WS_ROPE); const float* rs = rc + SEQ * 32;
    if (pn < 16) {
        const int c0 = 64 * pn;
        if (j < 64) U[(size_t)r * D + c0 + j] = (bf16_t)f2bf(v1 * v0);
        else        G[(size_t)r * D + c0 + (j - 64)] = (bf16_t)f2bf(v1 * sigmoidf_(v1) * v0);
    } else if (pn < 20) {
        const int hh = j >> 5, d = j & 31, head = 4 * (pn - 16) + hh, pos = r & (SEQ - 1);
        const float c = rc[pos * 32 + d], s = rs[pos * 32 + d];
        Q[(size_t)r * D + head * 64 + d] = (bf16_t)f2bf((v0 * c - v1 * s) * QSCALE);
        Q[(size_t)r * D + head * 64 + 32 + d] = (bf16_t)f2bf((v1 * c + v0 * s) * QSCALE);
    } else if (pn == 20) {
        if (j < 64) { const int hh = j >> 5, d = j & 31, pos = r & (SEQ - 1); const float c = rc[pos * 32 + d], s = rs[pos * 32 + d];
            KV[(size_t)r * 256 + hh * 64 + d] = (bf16_t)f2bf(v0 * c - v1 * s); KV[(size_t)r * 256 + hh * 64 + 32 + d] = (bf16_t)f2bf(v1 * c + v0 * s); }
        else { KV[(size_t)r * 256 + 128 + (j - 64)] = (bf16_t)f2bf(v0); KV[(size_t)r * 256 + 192 + (j - 64)] = (bf16_t)f2bf(v1); }
    } else if (pn < 25) {
        const int c = 256 * (pn - 21) + j;
        ZA[(size_t)r * D + c] = (bf16_t)f2bf(v0 * sigmoidf_(v0)); ZA[(size_t)r * D + c + 128] = (bf16_t)f2bf(v1 * sigmoidf_(v1));
    } else {
        const int c = 128 * (pn - 25) + j;
        const float ga = fminf(fmaxf(v0, -60.f), 60.f), gb = fminf(fmaxf(v1, -60.f), 60.f);
        const float ea = __expf(-ga), eb = __expf(-gb);
        SB[(size_t)r * D + c] = (bf16_t)f2bf(1.f / (1.f + eb));
        R[(size_t)r * D + c] = (bf16_t)f2bf((1.f + eb) / (1.f + ea));
    }
}

namespace nv {
__global__ void prep_weights(Ptrs p) {
    const size_t tid = (size_t)blockIdx.x * blockDim.x + threadIdx.x, nth = (size_t)gridDim.x * blockDim.x;
    bf16_t* win_t = (bf16_t*)(p.ws + WS_WIN_T); bf16_t* wcat_t = (bf16_t*)(p.ws + WS_WCAT_T); bf16_t* wo_t = (bf16_t*)(p.ws + WS_WO_T);
    for (size_t i = tid; i < (size_t)DIN * D; i += nth) { const int n = (int)(i / D), k = (int)(i % D); win_t[i] = (bf16_t)f2bf(p.w_in[(size_t)k * DIN + win_src_col(n >> 8, n & 255)]); }
    for (size_t i = tid; i < (size_t)D * 2 * D; i += nth) { const int n = (int)(i / (2 * D)), k = (int)(i % (2 * D)); wcat_t[i] = (bf16_t)f2bf(k < D ? p.w_pc[(size_t)k * D + n] : p.w_pa[(size_t)(k - D) * D + n]); }
    for (size_t i = tid; i < (size_t)D * D; i += nth) { const int n = (int)(i / D), k = (int)(i % D); wo_t[i] = (bf16_t)f2bf(p.w_out[(size_t)k * D + n]); }
    float* rc = (float*)(p.ws + WS_ROPE); float* rs = rc + SEQ * 32;
    for (size_t i = tid; i < (size_t)SEQ * 32; i += nth) { const int pos = (int)(i / 32), d = (int)(i % 32);
        const float inv = (float)pow(10000.0, -(double)d / 32.0); const float ang = (float)pos * inv;
        rc[i] = (float)cos((double)ang); rs[i] = (float)sin((double)ang); }
}
__global__ void prep_xn(Ptrs p) {
    const int lane = threadIdx.x & 63; const int row = blockIdx.x * (blockDim.x >> 6) + (threadIdx.x >> 6);
    const f32x4* xr = (const f32x4*)(p.x + (size_t)row * D) + lane; const f32x4* gr = (const f32x4*)p.g_pre + lane;
    f32x4 v[4]; float s = 0.f;
#pragma unroll
    for (int j = 0; j < 4; ++j) { v[j] = xr[64 * j]; s += (v[j].x * v[j].x + v[j].y * v[j].y) + (v[j].z * v[j].z + v[j].w * v[j].w); }
#pragma unroll
    for (int o = 1; o < 64; o <<= 1) s += __shfl_xor(s, o);
    const float rstd = 1.f / sqrtf(s * (1.f / D) + RMS_EPS);
    unsigned long long* o8 = (unsigned long long*)((bf16_t*)(p.ws + WS_XN) + (size_t)row * D) + lane;
#pragma unroll
    for (int j = 0; j < 4; ++j) { const f32x4 g = gr[64 * j];
        const unsigned lo = f2bf(v[j].x * rstd * g.x) | (f2bf(v[j].y * rstd * g.y) << 16), hi = f2bf(v[j].z * rstd * g.z) | (f2bf(v[j].w * rstd * g.w) << 16);
        o8[64 * j] = (unsigned long long)lo | ((unsigned long long)hi << 32); }
}
__device__ __forceinline__ void tile32(const bf16_t* A, int lda, const bf16_t* Bt, int ldb, int K, int row0, int col0, f32x16& acc, int lane) {
    const int r = lane & 31, h = lane >> 5;
    const bf16_t* ap = A + (size_t)(row0 + r) * lda + 8 * h; const bf16_t* bp = Bt + (size_t)(col0 + r) * ldb + 8 * h;
    for (int k = 0; k < K; k += 16) { const bf16x8 a = *(const bf16x8*)(ap + k), b = *(const bf16x8*)(bp + k); acc = __builtin_amdgcn_mfma_f32_32x32x16_bf16(a, b, acc, 0, 0, 0); }
}
__device__ __forceinline__ int crow(int reg, int h) { return (reg & 3) + 8 * (reg >> 2) + 4 * h; }
__global__ void gemm1(Ptrs p) {
    const int lane = threadIdx.x & 63, w = threadIdx.x >> 6; const int pn = blockIdx.x % NT1, row0 = (blockIdx.x / NT1) * 32, j0 = 32 * w;
    const bf16_t* A = (const bf16_t*)(p.ws + WS_XN); const bf16_t* Bt = (const bf16_t*)(p.ws + WS_WIN_T);
    f32x16 a0 = {}, a1 = {};
    tile32(A, D, Bt, D, D, row0, pn * 256 + j0, a0, lane); tile32(A, D, Bt, D, D, row0, pn * 256 + 128 + j0, a1, lane);
    const int h = lane >> 5, c = lane & 31;
#pragma unroll
    for (int r = 0; r < 16; ++r) epi_pair(p.ws, pn, row0 + crow(r, h), j0 + c, a0[r], a1[r]);
}
__global__ void conv(Ptrs p) {
    const size_t i = (size_t)blockIdx.x * blockDim.x + threadIdx.x; const int r = (int)(i / D), c = (int)(i % D), t = r & (SEQ - 1);
    const bf16_t* U = (const bf16_t*)(p.ws + WS_U); bf16_t* G = (bf16_t*)(p.ws + WS_G);
    const float w0 = p.w_conv[c], w1 = p.w_conv[D + c], w2 = p.w_conv[2 * D + c];
    float y = w2 * bf2f(U[i]); if (t >= 1) y += w1 * bf2f(U[i - D]); if (t >= 2) y += w0 * bf2f(U[i - 2 * D]);
    G[i] = (bf16_t)f2bf(bf2f(G[i]) * y);
}
__global__ void attn(Ptrs p) {
    const int lane = threadIdx.x & 63; const size_t wv = (size_t)blockIdx.x * (blockDim.x >> 6) + (threadIdx.x >> 6);
    const int r = (int)(wv / NHEAD), h = (int)(wv % NHEAD), t = r & (SEQ - 1), kh = h / GROUP;
    bf16_t* Q = (bf16_t*)(p.ws + WS_Q); const bf16_t* KV = (const bf16_t*)(p.ws + WS_KV); const bf16_t* ZA = (const bf16_t*)(p.ws + WS_ZA);
    const float qd = bf2f(Q[(size_t)r * D + h * 64 + lane]);
    float l0 = 0.f, l1 = 0.f;
    for (int d = 0; d < 64; ++d) { const float q = __shfl(qd, d);
        if (t - lane >= 0) l0 += q * bf2f(KV[(size_t)(r - lane) * 256 + kh * 64 + d]);
        if (t - 64 - lane >= 0) l1 += q * bf2f(KV[(size_t)(r - 64 - lane) * 256 + kh * 64 + d]); }
    if (t - lane < 0) l0 = -INFINITY; if (t - 64 - lane < 0) l1 = -INFINITY;
    const float sk = p.sinks[h] * LOG2E;
    float m = fmaxf(fmaxf(l0, l1), sk);
#pragma unroll
    for (int o = 1; o < 64; o <<= 1) m = fmaxf(m, __shfl_xor(m, o));
    const float p0 = exp2f(l0 - m), p1 = exp2f(l1 - m);
    float s = p0 + p1;
#pragma unroll
    for (int o = 1; o < 64; o <<= 1) s += __shfl_xor(s, o);
    s += exp2f(sk - m);
    float o = 0.f;
    for (int kk = 0; kk < 64; ++kk) { const float a = __shfl(p0, kk), b = __shfl(p1, kk);
        if (t - kk >= 0) o += a * bf2f(KV[(size_t)(r - kk) * 256 + 128 + kh * 64 + lane]);
        if (t - 64 - kk >= 0) o += b * bf2f(KV[(size_t)(r - 64 - kk) * 256 + 128 + kh * 64 + lane]); }
    o /= s;
    Q[(size_t)r * D + h * 64 + lane] = (bf16_t)f2bf(bf2f(ZA[(size_t)r * D + h * 64 + lane]) * o);
}
__global__ void gemm_merge(Ptrs p) {
    const int lane = threadIdx.x & 63; const size_t wv = (size_t)blockIdx.x * (blockDim.x >> 6) + (threadIdx.x >> 6);
    const int row0 = (int)(wv / 32) * 32, col0 = (int)(wv % 32) * 32;
    const bf16_t* UA = (const bf16_t*)(p.ws + WS_G); const bf16_t* UB = (const bf16_t*)(p.ws + WS_Q); const bf16_t* Wc = (const bf16_t*)(p.ws + WS_WCAT_T);
    const bf16_t* R = (const bf16_t*)(p.ws + WS_R); const bf16_t* SB = (const bf16_t*)(p.ws + WS_SB); bf16_t* MG = (bf16_t*)(p.ws + WS_XN);
    f32x16 acc = {};
    tile32(UA, D, Wc, 2 * D, D, row0, col0, acc, lane);
    const int h = lane >> 5, c = col0 + (lane & 31);
#pragma unroll
    for (int r = 0; r < 16; ++r) acc[r] *= bf2f(R[(size_t)(row0 + crow(r, h)) * D + c]);
    tile32(UB, D, Wc + D, 2 * D, D, row0, col0, acc, lane);
#pragma unroll
    for (int r = 0; r < 16; ++r) { const size_t o = (size_t)(row0 + crow(r, h)) * D + c; MG[o] = (bf16_t)f2bf(acc[r] * bf2f(SB[o])); }
}
__global__ void gemm_out(Ptrs p) {
    const int lane = threadIdx.x & 63; const size_t wv = (size_t)blockIdx.x * (blockDim.x >> 6) + (threadIdx.x >> 6);
    const int row0 = (int)(wv / 32) * 32, col0 = (int)(wv % 32) * 32;
    f32x16 acc = {};
    tile32((const bf16_t*)(p.ws + WS_XN), D, (const bf16_t*)(p.ws + WS_WO_T), D, D, row0, col0, acc, lane);
    const int h = lane >> 5, c = col0 + (lane & 31);
#pragma unroll
    for (int r = 0; r < 16; ++r) p.out[(size_t)(row0 + crow(r, h)) * D + c] = acc[r];
}
__global__ void finalize(Ptrs p) {
    const int lane = threadIdx.x & 63; const int row = blockIdx.x * (blockDim.x >> 6) + (threadIdx.x >> 6);
    f32x4* yr = (f32x4*)(p.out + (size_t)row * D) + lane; const f32x4* xr = (const f32x4*)(p.x + (size_t)row * D) + lane; const f32x4* gr = (const f32x4*)p.g_post + lane;
    f32x4 v[4]; float s = 0.f;
#pragma unroll
    for (int j = 0; j < 4; ++j) { v[j] = yr[64 * j]; s += (v[j].x * v[j].x + v[j].y * v[j].y) + (v[j].z * v[j].z + v[j].w * v[j].w); }
#pragma unroll
    for (int o = 1; o < 64; o <<= 1) s += __shfl_xor(s, o);
    const float rstd = 1.f / sqrtf(s * (1.f / D) + RMS_EPS);
#pragma unroll
    for (int j = 0; j < 4; ++j) yr[64 * j] = xr[64 * j] + v[j] * rstd * gr[64 * j];
}
}


namespace pg8 {
#define PG8_LAS __attribute__((address_space(3)))
constexpr int BM = 256, BK = 64, HALF = 128, HTB = HALF * BK * 2  , STAGE_BYTES = 8 * HTB, NXCD = 8, WGM = 8;

__host__ __device__ __forceinline__ int lds_byte(int r, int c) { const int st = (r >> 4) * 2 + (c >> 5), rr = r & 15, cc = c & 31, ob = rr * 64 + cc * 2; return st * 1024 + (ob ^ (((ob >> 9) & 1) << 5)); }
__host__ __device__ __forceinline__ void stage_rc(int b, int& R, int& C) { const int st = b / 1024, sb = b % 1024, swz = sb ^ (((sb >> 9) & 1) << 5); R = (st >> 1) * 16 + swz / 64; C = (st & 1) * 32 + (swz % 64) / 2; }
__host__ __device__ __forceinline__ int perm32(int rho) { const int n = rho >> 4, i = rho & 15; return 8 * (i >> 2) + 4 * n + (i & 3); }

struct Unit { int pm, pn; };
struct Gemm { const bf16_t* A; const bf16_t* Bt; int lda, ldb, M, N, K; int ksplit; long adelta; };

struct StaticOrder {
    int nM, nN, nwg, G, c;
    __host__ __device__ void init(int M_, int N_, int G_, int c_) { nM = M_ / BM; nN = N_ / BM; nwg = nM * nN; G = G_; c = c_; }
    __host__ __device__ bool next(int i, Unit& u) const {
        const long L = (long)i * G + c; if (L >= nwg) return false;
        int wgid = (int)L; { const int q = nwg / NXCD, r = nwg % NXCD, xcd = wgid % NXCD, off = wgid / NXCD; wgid = (xcd < r ? xcd * (q + 1) : r * (q + 1) + (xcd - r) * q) + off; }
        const int nig = WGM * nN, gid = wgid / nig, fm = gid * WGM, gsz = (nM - fm) < WGM ? (nM - fm) : WGM;
        u.pm = fm + ((wgid % nig) % gsz); u.pn = (wgid % nig) / gsz; return true;
    }
};

template <class Epi, class Sched, bool ALIGN_EPI>
__device__ __forceinline__ void gemm_phase(PG8_LAS unsigned char* lds, const Gemm g, const Sched& S, const Epi& E) {
    const int tid = threadIdx.x, wid = __builtin_amdgcn_readfirstlane(tid >> 6), lane = tid & 63, wr = wid >> 2, wc = wid & 3, fr = lane & 15, fq = lane >> 4;
    const int nt = g.K / BK;
    unsigned voffA[2], voffB[2];
#pragma unroll
    for (int i = 0; i < 2; ++i) { int R, C; stage_rc(tid * 16 + i * 8192, R, C); const int Rb = Epi::PERM ? ((R & ~31) + perm32(R & 31)) : R;
        voffA[i] = (unsigned)(R * g.lda + C) * 2u; voffB[i] = (unsigned)(Rb * g.ldb + C) * 2u; }
    const size_t kstep = (size_t)(BK * 2);
    const size_t hstepA = (size_t)HALF * g.lda * 2, hstepB = (size_t)HALF * g.ldb * 2;
    const size_t tstepA = 2 * hstepA, tstepB = 2 * hstepB;
    const unsigned ldsw = (unsigned)wid * 1024u;
    const int aoff = lds_byte(wr * 64 + fr, fq * 8), boff = lds_byte(wc * 32 + fr, fq * 8);
#define PG8_SA(b, h) (((b) * 2 + (h)) * HTB)
#define PG8_SB(b, h) ((4 + (b) * 2 + (h)) * HTB)
#define PG8_STAGE(bufoff, gbase, voff) do { _Pragma("unroll") for (int _i = 0; _i < 2; ++_i) \
        __builtin_amdgcn_global_load_lds((const unsigned*)((const char*)(gbase) + (voff)[_i]), (PG8_LAS unsigned*)(lds + (bufoff) + ldsw + _i * 8192), 16, 0, 0); } while (0)
#define PG8_LDA(dst, b, h) do { _Pragma("unroll") for (int m = 0; m < 4; ++m) _Pragma("unroll") for (int k = 0; k < 2; ++k) dst[m][k] = *(const PG8_LAS bf16x8*)(lds + PG8_SA(b, h) + aoff + m * 2048 + k * 1024); } while (0)
#define PG8_LDB(dst, b, h) do { _Pragma("unroll") for (int n = 0; n < 2; ++n) _Pragma("unroll") for (int k = 0; k < 2; ++k) dst[n][k] = *(const PG8_LAS bf16x8*)(lds + PG8_SB(b, h) + boff + n * 2048 + k * 1024); } while (0)
#define PG8_MMA(ai, bj, At, Bt) do { __builtin_amdgcn_s_setprio(1); _Pragma("unroll") for (int m = 0; m < 4; ++m) _Pragma("unroll") for (int n = 0; n < 2; ++n) _Pragma("unroll") for (int k = 0; k < 2; ++k) \
        acc[ai][bj][m][n] = __builtin_amdgcn_mfma_f32_16x16x32_bf16(Bt[n][k], At[m][k], acc[ai][bj][m][n], 0, 0, 0); __builtin_amdgcn_s_setprio(0); } while (0)
#define PG8_WAIT_V(n) asm volatile("s_waitcnt vmcnt(" #n ")" ::: "memory")
#define PG8_WAIT_L(n) asm volatile("s_waitcnt lgkmcnt(" #n ")" ::: "memory")
#define PG8_BAR __builtin_amdgcn_s_barrier()
#define PG8_SCHED __builtin_amdgcn_sched_barrier(0)
    Unit cur, nxt; int ui = 0;
    if (!S.next(0, cur)) return;
    f32x4 acc[2][2][4][2];
#pragma unroll
    for (int a = 0; a < 2; ++a)
#pragma unroll
        for (int b = 0; b < 2; ++b)
#pragma unroll
            for (int m = 0; m < 4; ++m)
#pragma unroll
                for (int n = 0; n < 2; ++n) acc[a][b][m][n] = (f32x4){0.f, 0.f, 0.f, 0.f};
    bf16x8 At[4][2], B0[2][2], B1[2][2];
    const char* cA = (const char*)g.A + (size_t)cur.pm * tstepA; const char* cB = (const char*)g.Bt + (size_t)cur.pn * tstepB;
    PG8_STAGE(PG8_SB(0, 0), cB, voffB); PG8_STAGE(PG8_SB(0, 1), cB + hstepB, voffB); PG8_STAGE(PG8_SA(0, 0), cA, voffA); PG8_STAGE(PG8_SA(0, 1), cA + hstepA, voffA);
    if (wr == 1) PG8_BAR;
    PG8_WAIT_V(2); PG8_BAR;
    PG8_STAGE(PG8_SB(1, 0), cB + kstep, voffB); PG8_STAGE(PG8_SA(1, 0), cA + kstep, voffA); PG8_STAGE(PG8_SB(1, 1), cB + hstepB + kstep, voffB);
    PG8_WAIT_V(6); PG8_BAR;
    for (;;) {
        const bool has_next = S.next(ui + 1, nxt);
        const char* nA = has_next ? (const char*)g.A + (size_t)nxt.pm * tstepA : cA; const char* nB = has_next ? (const char*)g.Bt + (size_t)nxt.pn * tstepB : cB;
        for (int t = 0; t < nt; t += 2) {
            const bool last = (t == nt - 2);
            const char* a1 = cA + (size_t)(t + 1) * kstep + ((t + 1) >= g.ksplit ? g.adelta : 0l);
            const char* a2 = last ? nA : cA + (size_t)(t + 2) * kstep + ((t + 2) >= g.ksplit ? g.adelta : 0l);
            const char* b2 = last ? nB : cB + (size_t)(t + 2) * kstep;
            const char* a3 = a2 + kstep; const char* b3 = b2 + kstep;
            if constexpr (Epi::MID) { if (t == g.ksplit) { int fr_ = fr, fq_ = fq; asm volatile("" : "+v"(fr_), "+v"(fq_)); E.mid(acc, cur, wr, wc, fr_, fq_); } }
            PG8_LDB(B0, 0, 0); PG8_LDB(B1, 0, 1); PG8_SCHED; PG8_LDA(At, 0, 0); PG8_STAGE(PG8_SA(1, 1), a1 + hstepA, voffA);
            PG8_WAIT_V(8); PG8_WAIT_L(0); PG8_BAR; PG8_MMA(0, 0, At, B0); PG8_MMA(0, 1, At, B1); PG8_BAR; PG8_SCHED;
            PG8_LDA(At, 0, 1); PG8_STAGE(PG8_SB(0, 0), b2, voffB); PG8_STAGE(PG8_SB(0, 1), b2 + hstepB, voffB); PG8_STAGE(PG8_SA(0, 0), a2, voffA);
            PG8_WAIT_V(8); PG8_WAIT_L(0); PG8_BAR; PG8_MMA(1, 0, At, B0); PG8_MMA(1, 1, At, B1); PG8_BAR; PG8_SCHED;
            PG8_LDB(B0, 1, 0); PG8_LDB(B1, 1, 1); PG8_SCHED; PG8_LDA(At, 1, 0); PG8_STAGE(PG8_SA(0, 1), a2 + hstepA, voffA);
            PG8_WAIT_V(8); PG8_WAIT_L(0); PG8_BAR; PG8_MMA(0, 0, At, B0); PG8_MMA(0, 1, At, B1); PG8_BAR; PG8_SCHED;
            PG8_LDA(At, 1, 1); PG8_STAGE(PG8_SB(1, 0), b3, voffB); PG8_STAGE(PG8_SB(1, 1), b3 + hstepB, voffB); PG8_STAGE(PG8_SA(1, 0), a3, voffA);
            PG8_WAIT_V(8); PG8_WAIT_L(0); PG8_BAR; PG8_MMA(1, 0, At, B0); PG8_MMA(1, 1, At, B1); PG8_BAR; PG8_SCHED;
        }
        if constexpr (ALIGN_EPI) { if (wr == 0) PG8_BAR; }
        { int fr_ = fr, fq_ = fq; asm volatile("" : "+v"(fr_), "+v"(fq_)); E(acc, cur, wr, wc, fr_, fq_); }
        if (!has_next) break;
#pragma unroll
        for (int a = 0; a < 2; ++a)
#pragma unroll
            for (int b = 0; b < 2; ++b)
#pragma unroll
                for (int m = 0; m < 4; ++m)
#pragma unroll
                    for (int n = 0; n < 2; ++n) acc[a][b][m][n] = (f32x4){0.f, 0.f, 0.f, 0.f};
        cur = nxt; cA = nA; cB = nB; ++ui;
        if constexpr (ALIGN_EPI) { if (wr == 1) PG8_BAR; }
    }
    PG8_WAIT_V(0);
    if constexpr (!ALIGN_EPI) { if (wr == 0) PG8_BAR; }
    PG8_BAR;
#undef PG8_SA
#undef PG8_SB
#undef PG8_STAGE
#undef PG8_LDA
#undef PG8_LDB
#undef PG8_MMA
#undef PG8_WAIT_V
#undef PG8_WAIT_L
#undef PG8_BAR
#undef PG8_SCHED
}

__device__ __forceinline__ float silu_f(float v) { return v * __builtin_amdgcn_rcpf(1.f + __builtin_amdgcn_exp2f(-LOG2E * v)); }
__device__ __forceinline__ u32x4 pack8(const float (&v)[8]) { u32x4 w; w.x = cvtpk(v[0], v[1]); w.y = cvtpk(v[2], v[3]); w.z = cvtpk(v[4], v[5]); w.w = cvtpk(v[6], v[7]); return w; }

struct EpiIn {
    static constexpr bool PERM = true, MID = false;
    unsigned char* ws;
    __device__ __forceinline__ void mid(f32x4 (&)[2][2][4][2], const Unit&, int, int, int, int) const {}
    __device__ __forceinline__ void operator()(const f32x4 (&acc)[2][2][4][2], const Unit& u, int wr, int wc, int fr, int fq) const {
        const int pn = u.pn, row0 = u.pm * BM + wr * 64 + fr, j0 = wc * 32 + 8 * fq;
        bf16_t* const Ub = (bf16_t*)(ws + WS_U); bf16_t* const Gb = (bf16_t*)(ws + WS_G); bf16_t* const Qb = (bf16_t*)(ws + WS_Q); bf16_t* const ZAb = (bf16_t*)(ws + WS_ZA);
        bf16_t* const Rb = (bf16_t*)(ws + WS_R); bf16_t* const SBb = (bf16_t*)(ws + WS_SB); bf16_t* const KVb = (bf16_t*)(ws + WS_KV);
        const float* const rc = (const float*)(ws + WS_ROPE); const float* const rs = rc + SEQ * 32;
#pragma unroll
        for (int ai = 0; ai < 2; ++ai)
#pragma unroll
            for (int m = 0; m < 4; ++m) {
                const int row = row0 + ai * HALF + m * 16;
                float v0[8], v1[8], o0[8], o1[8];
#pragma unroll
                for (int e = 0; e < 4; ++e) { v0[e] = acc[ai][0][m][0][e]; v0[4 + e] = acc[ai][0][m][1][e]; v1[e] = acc[ai][1][m][0][e]; v1[4 + e] = acc[ai][1][m][1][e]; }
                if (pn < 16) {
                    if (wc < 2) {
#pragma unroll
                        for (int e = 0; e < 8; ++e) o0[e] = v1[e] * v0[e];
                        *(u32x4*)(Ub + (size_t)row * D + 64 * pn + j0) = pack8(o0);
                    } else {
#pragma unroll
                        for (int e = 0; e < 8; ++e) o0[e] = silu_f(v1[e]) * v0[e];
                        *(u32x4*)(Gb + (size_t)row * D + 64 * pn + (j0 - 64)) = pack8(o0);
                    }
                } else if (pn < 20 || (pn == 20 && wc < 2)) {
                    const int pos = row & (SEQ - 1), d0 = 8 * fq;
                    const f32x4 c0 = *(const f32x4*)(rc + pos * 32 + d0), c1 = *(const f32x4*)(rc + pos * 32 + d0 + 4), s0 = *(const f32x4*)(rs + pos * 32 + d0), s1 = *(const f32x4*)(rs + pos * 32 + d0 + 4);
                    const float sc = (pn < 20) ? QSCALE : 1.f;
#pragma unroll
                    for (int e = 0; e < 8; ++e) { const float c = e < 4 ? c0[e] : c1[e - 4], s = e < 4 ? s0[e] : s1[e - 4]; o0[e] = (v0[e] * c - v1[e] * s) * sc; o1[e] = (v1[e] * c + v0[e] * s) * sc; }
                    bf16_t* dst = (pn < 20) ? Qb + (size_t)row * D + (4 * (pn - 16) + wc) * 64 + d0 : KVb + (size_t)row * 256 + wc * 64 + d0;
                    *(u32x4*)dst = pack8(o0); *(u32x4*)(dst + 32) = pack8(o1);
                } else if (pn == 20) {
                    const int jj = 32 * (wc - 2) + 8 * fq;
                    *(u32x4*)(KVb + (size_t)row * 256 + 128 + jj) = pack8(v0); *(u32x4*)(KVb + (size_t)row * 256 + 192 + jj) = pack8(v1);
                } else if (pn < 25) {
#pragma unroll
                    for (int e = 0; e < 8; ++e) { o0[e] = silu_f(v0[e]); o1[e] = silu_f(v1[e]); }
                    bf16_t* dst = ZAb + (size_t)row * D + 256 * (pn - 21) + j0;
                    *(u32x4*)dst = pack8(o0); *(u32x4*)(dst + 128) = pack8(o1);
                } else {
#pragma unroll
                    for (int e = 0; e < 8; ++e) { const float ga = fminf(fmaxf(v0[e], -60.f), 60.f), gb = fminf(fmaxf(v1[e], -60.f), 60.f);
                        const float ea = __builtin_amdgcn_exp2f(-LOG2E * ga), eb = __builtin_amdgcn_exp2f(-LOG2E * gb);
                        o0[e] = __builtin_amdgcn_rcpf(1.f + eb); o1[e] = (1.f + eb) * __builtin_amdgcn_rcpf(1.f + ea); }
                    const size_t off = (size_t)row * D + 128 * (pn - 25) + j0;
                    *(u32x4*)(SBb + off) = pack8(o0); *(u32x4*)(Rb + off) = pack8(o1);
                }
            }
    }
};

struct EpiMerge {
    static constexpr bool PERM = true, MID = true;
    const bf16_t* R; const bf16_t* SB; bf16_t* MG;
    __device__ __forceinline__ void mid(f32x4 (&acc)[2][2][4][2], const Unit& u, int wr, int wc, int fr, int fq) const {
        const bf16_t* rp = R + (size_t)(u.pm * BM + wr * 64 + fr) * D + u.pn * BM + wc * 32 + 8 * fq;
#pragma unroll
        for (int ai = 0; ai < 2; ++ai)
#pragma unroll
            for (int m = 0; m < 4; ++m) {
#pragma unroll
                for (int bj = 0; bj < 2; ++bj) { const u32x4 w = *(const u32x4*)(rp + (size_t)(ai * HALF + m * 16) * D + bj * HALF);
                    acc[ai][bj][m][0] *= (f32x4){bflo(w.x), bfhi(w.x), bflo(w.y), bfhi(w.y)}; acc[ai][bj][m][1] *= (f32x4){bflo(w.z), bfhi(w.z), bflo(w.w), bfhi(w.w)}; }
                if (m & 1) asm volatile("" ::: "memory"); }
    }
    __device__ __forceinline__ void operator()(const f32x4 (&acc)[2][2][4][2], const Unit& u, int wr, int wc, int fr, int fq) const {
        const size_t base = (size_t)(u.pm * BM + wr * 64 + fr) * D + u.pn * BM + wc * 32 + 8 * fq;
#pragma unroll
        for (int ai = 0; ai < 2; ++ai)
#pragma unroll
            for (int m = 0; m < 4; ++m) {
#pragma unroll
                for (int bj = 0; bj < 2; ++bj) { const size_t off = base + (size_t)(ai * HALF + m * 16) * D + bj * HALF; const u32x4 w = *(const u32x4*)(SB + off);
                    const f32x4 a = acc[ai][bj][m][0] * (f32x4){bflo(w.x), bfhi(w.x), bflo(w.y), bfhi(w.y)}, b = acc[ai][bj][m][1] * (f32x4){bflo(w.z), bfhi(w.z), bflo(w.w), bfhi(w.w)};
                    u32x4 o; o.x = cvtpk(a[0], a[1]); o.y = cvtpk(a[2], a[3]); o.z = cvtpk(b[0], b[1]); o.w = cvtpk(b[2], b[3]); *(u32x4*)(MG + off) = o; }
                if (m & 1) asm volatile("" ::: "memory"); }
    }
};

struct EpiOutF32 {
    static constexpr bool PERM = false, MID = false;
    float* out;
    __device__ __forceinline__ void mid(f32x4 (&)[2][2][4][2], const Unit&, int, int, int, int) const {}
    __device__ __forceinline__ void operator()(const f32x4 (&acc)[2][2][4][2], const Unit& u, int wr, int wc, int fr, int fq) const {
        const int row0 = u.pm * BM + wr * 64 + fr, col0 = u.pn * BM + wc * 32 + 4 * fq;
#pragma unroll
        for (int ai = 0; ai < 2; ++ai)
#pragma unroll
            for (int m = 0; m < 4; ++m)
#pragma unroll
                for (int bj = 0; bj < 2; ++bj)
#pragma unroll
                    for (int n = 0; n < 2; ++n) *(f32x4*)(out + (size_t)(row0 + ai * HALF + m * 16) * D + col0 + bj * HALF + n * 16) = acc[ai][bj][m][n];
    }
};
}

namespace att {
#define ATT_LAS __attribute__((address_space(3)))
typedef short v4i16_t __attribute__((ext_vector_type(4)));
typedef short s16x4 __attribute__((ext_vector_type(4)));
constexpr int KIMG = 0, VIMG = 32768, WSF = 65536, OST = WSF + 2048, LDS_BYTES = OST + 8 * 4096;
__device__ __forceinline__ int crow(int r, int hi) { return (r & 3) + 8 * (r >> 2) + 4 * hi; }
__device__ __forceinline__ void glds16(const void* gsrc, unsigned lds_dst) { unsigned keep;
    asm volatile("s_mov_b32 %0, m0\n\ts_mov_b32 m0, %2\n\ts_nop 0\n\tglobal_load_lds_dwordx4 %1, off\n\ts_mov_b32 m0, %0" : "=&s"(keep) : "v"(gsrc), "s"(lds_dst) : "memory"); }
__device__ __forceinline__ s16x4 vtr(const ATT_LAS char* p) { return __builtin_bit_cast(s16x4, __builtin_amdgcn_ds_read_tr16_b64_v4i16((ATT_LAS v4i16_t*)p)); }

template <bool LO, bool HI, bool KMIN> __device__ __forceinline__ void mask_tile(f32x16& p0, f32x16& p1, int kb, int qi, int hi, int kmin) {
    const float NEG = -INFINITY;
#pragma unroll
    for (int r = 0; r < 16; ++r) { const int k0 = kb + crow(r, hi), k1 = k0 + 32;
        bool ok0 = true, ok1 = true;
        if (LO) { ok0 = ok0 && (k0 > qi); ok1 = ok1 && (k1 > qi); }
        if (HI) { ok0 = ok0 && (k0 <= qi + 128); ok1 = ok1 && (k1 <= qi + 128); }
        if (KMIN) { ok0 = ok0 && (k0 >= kmin); ok1 = ok1 && (k1 >= kmin); }
        p0[r] = ok0 ? p0[r] : NEG; p1[r] = ok1 ? p1[r] : NEG; }
}
__device__ __forceinline__ float max16(const f32x16& p, float m) {
#pragma unroll
    for (int r = 0; r < 16; ++r) m = fmaxf(m, p[r]);
    return m;
}

__device__ __forceinline__ void attn_unit(int b, int kh, int j, bf16_t* Qb, const bf16_t* KVb, const bf16_t* ZAb, const float* sinks, ATT_LAS char* shm3) {
    const int tid = threadIdx.x, lane = tid & 63, r32 = lane & 31, hi = lane >> 5; const int wid = __builtin_amdgcn_readfirstlane(tid >> 6);
    const int head = kh * GROUP + wid; const long rowb = (long)b * SEQ; const int q0 = 128 * j;
    const unsigned lds0 = (unsigned)(uintptr_t)shm3;
#pragma unroll
    for (int T = 0; T < 4; ++T) {
        int kv0 = q0 - 128 + 64 * T; if (kv0 < 0) kv0 += 128;
        const bf16_t* ksrc = KVb + (size_t)(rowb + kv0 + lane) * 256 + kh * 64 + wid * 8;
        glds16(ksrc, (unsigned)__builtin_amdgcn_readfirstlane(lds0 + KIMG + T * 8192 + wid * 1024));
        const bf16_t* vsrc = KVb + (size_t)(rowb + kv0 + 16 * (wid & 3) + (lane >> 2)) * 256 + 128 + kh * 64 + (wid >> 2) * 32 + (lane & 3) * 8;
        glds16(vsrc, (unsigned)__builtin_amdgcn_readfirstlane(lds0 + VIMG + T * 8192 + wid * 1024));
    }
    ATT_LAS float* wsf = (ATT_LAS float*)(shm3 + WSF) + wid * 64;
    ATT_LAS bf16_t* stg = (ATT_LAS bf16_t*)(shm3 + OST) + wid * 2048;
    const float sink2 = sinks[head] * LOG2E;
    const int kmin = (j == 0) ? 128 : 0;
    asm volatile("s_waitcnt vmcnt(0)\n\ts_barrier" ::: "memory");
    for (int i = 0; i < 4; ++i) {
        const int T0 = i >> 1; const int qi = 32 * i + r32;
        const bf16_t* qrow = Qb + (size_t)(rowb + q0 + qi) * D + head * 64;
        bf16x8 qr[4];
#pragma unroll
        for (int d0 = 0; d0 < 4; ++d0) qr[d0] = *(const bf16x8*)(qrow + d0 * 16 + hi * 8);
        f32x16 s0[3], s1[3];
#pragma unroll
        for (int tt = 0; tt < 3; ++tt) {
            const ATT_LAS char* kb = shm3 + KIMG + (T0 + tt) * 8192 + hi * 1024 + r32 * 16;
            f32x16 a = {}, c = {};
#pragma unroll
            for (int d0 = 0; d0 < 4; ++d0) { const bf16x8 k0 = *(const ATT_LAS bf16x8*)(kb + d0 * 2048), k1 = *(const ATT_LAS bf16x8*)(kb + d0 * 2048 + 512);
                a = __builtin_amdgcn_mfma_f32_32x32x16_bf16(k0, qr[d0], a, 0, 0, 0); c = __builtin_amdgcn_mfma_f32_32x32x16_bf16(k1, qr[d0], c, 0, 0, 0); }
            s0[tt] = a; s1[tt] = c;
        }
        if (kmin) { mask_tile<true, true, true>(s0[0], s1[0], 64 * T0 + 0, qi, hi, kmin); mask_tile<true, true, true>(s0[1], s1[1], 64 * T0 + 64, qi, hi, kmin); mask_tile<true, true, true>(s0[2], s1[2], 64 * T0 + 128, qi, hi, kmin); }
        else { mask_tile<true, false, false>(s0[0], s1[0], 64 * T0, qi, hi, 0); mask_tile<false, true, false>(s0[2], s1[2], 64 * T0 + 128, qi, hi, 0); }
        float mx = sink2;
#pragma unroll
        for (int tt = 0; tt < 3; ++tt) { mx = max16(s0[tt], mx); mx = max16(s1[tt], mx); }
        { auto rr = __builtin_amdgcn_permlane32_swap(__float_as_uint(mx), __float_as_uint(mx), false, false); mx = fmaxf(__uint_as_float(rr[0]), __uint_as_float(rr[1])); }
        float l = 0.f;
#pragma unroll
        for (int tt = 0; tt < 3; ++tt)
#pragma unroll
            for (int r = 0; r < 16; ++r) { s0[tt][r] = __builtin_amdgcn_exp2f(s0[tt][r] - mx); s1[tt][r] = __builtin_amdgcn_exp2f(s1[tt][r] - mx); l += s0[tt][r] + s1[tt][r]; }
        { auto rr = __builtin_amdgcn_permlane32_swap(__float_as_uint(l), __float_as_uint(l), false, false); l = __uint_as_float(rr[0]) + __uint_as_float(rr[1]); }
        l += __builtin_amdgcn_exp2f(sink2 - mx);
        f32x16 o[2]; o[0] = f32x16{}; o[1] = f32x16{};
#pragma unroll
        for (int tt = 0; tt < 3; ++tt) {
            u32x4 pw[4];
            pw[0] = (u32x4){cvtpk(s0[tt][0], s0[tt][1]), cvtpk(s0[tt][2], s0[tt][3]), cvtpk(s0[tt][4], s0[tt][5]), cvtpk(s0[tt][6], s0[tt][7])};
            pw[1] = (u32x4){cvtpk(s0[tt][8], s0[tt][9]), cvtpk(s0[tt][10], s0[tt][11]), cvtpk(s0[tt][12], s0[tt][13]), cvtpk(s0[tt][14], s0[tt][15])};
            pw[2] = (u32x4){cvtpk(s1[tt][0], s1[tt][1]), cvtpk(s1[tt][2], s1[tt][3]), cvtpk(s1[tt][4], s1[tt][5]), cvtpk(s1[tt][6], s1[tt][7])};
            pw[3] = (u32x4){cvtpk(s1[tt][8], s1[tt][9]), cvtpk(s1[tt][10], s1[tt][11]), cvtpk(s1[tt][12], s1[tt][13]), cvtpk(s1[tt][14], s1[tt][15])};
            const ATT_LAS char* vp = shm3 + VIMG + (T0 + tt) * 8192 + ((lane >> 4) & 1) * 32 + (lane & 3) * 8 + (4 * hi + ((lane & 15) >> 2)) * 64;
#pragma unroll
            for (int d0 = 0; d0 < 2; ++d0)
#pragma unroll
                for (int ks = 0; ks < 4; ++ks) { const s16x4 lo = vtr(vp + d0 * 4096 + ks * 1024), hh = vtr(vp + d0 * 4096 + ks * 1024 + 512);
                    const bf16x8 vf = (bf16x8){lo[0], lo[1], lo[2], lo[3], hh[0], hh[1], hh[2], hh[3]};
                    o[d0] = __builtin_amdgcn_mfma_f32_32x32x16_bf16(__builtin_bit_cast(bf16x8, pw[ks]), vf, o[d0], 0, 0, 0); }
        }
        if (hi == 0) wsf[r32] = l;
        asm volatile("s_waitcnt lgkmcnt(0)" ::: "memory");
#pragma unroll
        for (int r = 0; r < 16; ++r) { const int orow = crow(r, hi); const float rl = __builtin_amdgcn_rcpf(wsf[orow]);
            stg[orow * 64 + r32] = (bf16_t)f2bf(o[0][r] * rl); stg[orow * 64 + 32 + r32] = (bf16_t)f2bf(o[1][r] * rl); }
        asm volatile("s_waitcnt lgkmcnt(0)" ::: "memory");
#pragma unroll
        for (int it = 0; it < 4; ++it) { const int row = it * 8 + (lane >> 3), ch = lane & 7;
            const u32x4 ov = *(const ATT_LAS u32x4*)(stg + row * 64 + ch * 8);
            const size_t goff = (size_t)(rowb + q0 + 32 * i + row) * D + head * 64 + ch * 8;
            const u32x4 zv = *(const u32x4*)(ZAb + goff);
            u32x4 w; w.x = cvtpk(bflo(ov.x) * bflo(zv.x), bfhi(ov.x) * bfhi(zv.x)); w.y = cvtpk(bflo(ov.y) * bflo(zv.y), bfhi(ov.y) * bfhi(zv.y));
            w.z = cvtpk(bflo(ov.z) * bflo(zv.z), bfhi(ov.z) * bfhi(zv.z)); w.w = cvtpk(bflo(ov.w) * bflo(zv.w), bfhi(ov.w) * bfhi(zv.w));
            *(u32x4*)(Qb + goff) = w; }
        asm volatile("s_waitcnt lgkmcnt(0)" ::: "memory");
    }
    asm volatile("s_waitcnt lgkmcnt(0)\n\ts_barrier" ::: "memory");
}
}

constexpr int NWAVES = 8;
constexpr int N_LAUNCHES = MK_N_LAUNCHES;
constexpr int PER_PHASE = 6;
constexpr int RING_OFF = 0, RING_BYTES = 131072;
constexpr int LDSCTL_OFF = RING_BYTES, MISC_OFF = LDSCTL_OFF + 320;
constexpr int LDS_BYTES = 147456;
static_assert(att::LDS_BYTES <= RING_BYTES, "attention scratch fits the ring region");

#define GAS __attribute__((address_space(1)))
#define LAS __attribute__((address_space(3)))
typedef GAS unsigned gu32;
#define RLX_AGENT __ATOMIC_RELAXED, __HIP_MEMORY_SCOPE_AGENT
#define LDS_WAIT() asm volatile("s_waitcnt lgkmcnt(0)" ::: "memory")
#define VM_WAIT() asm volatile("s_waitcnt vmcnt(0)" ::: "memory")

#define XB_TMO      128
#define XB_XCNT(j)  (256  + 64 * (j))
#define XB_XSUB(j)  (1280 + 64 * (j))
#define XB_XGEN(j)  (2304 + 64 * (j))
#define XB_TOP      3328
#define XB_TOPGEN   3392
#define XCD_BAR_WORDS 3456
#define XB_SPIN_CAP (1u << 18)
__device__ __forceinline__ unsigned xb_ld(unsigned* p)              { return __hip_atomic_load(p, __ATOMIC_RELAXED, __HIP_MEMORY_SCOPE_AGENT); }
__device__ __forceinline__ unsigned xb_add(unsigned* p, unsigned v) { return __hip_atomic_fetch_add(p, v, __ATOMIC_RELAXED, __HIP_MEMORY_SCOPE_AGENT); }
__device__ __forceinline__ unsigned xb_xcc_id() { return (unsigned)__builtin_amdgcn_s_getreg((3 << 11) | 20) & 0xFu; }
#define XB_SPIN(cond, bar) do { unsigned _sp = 0; while (cond) { __builtin_amdgcn_s_sleep(1); \
    if ((++_sp & 255u) == 0u) { if (xb_ld(&(bar)[XB_TMO])) break; if (_sp > XB_SPIN_CAP) { atomicAdd(&(bar)[XB_TMO], 1u); break; } } } } while (0)
struct XcdBarrier { unsigned* bar; unsigned x; volatile LAS unsigned* st; };
__device__ __forceinline__ XcdBarrier xcd_barrier_post(unsigned* bar, volatile LAS unsigned* st) {
    XcdBarrier b; b.bar = bar; b.x = xb_xcc_id(); b.st = st;
    if (threadIdx.x == 0) (void)xb_add(&bar[XB_XCNT(b.x)], 1u);
    return b;
}
__device__ __forceinline__ void xcd_barrier_complete(unsigned* bar, unsigned x, unsigned& nloc, unsigned& nx) {
    const unsigned G = gridDim.x * gridDim.y * gridDim.z;
    unsigned sum, cnt, mine, sp = 0u;
    for (;;) {
        sum = 0u; cnt = 0u; mine = 0u;
#pragma unroll
        for (unsigned j = 0; j < 16; ++j) { const unsigned c = xb_ld(&bar[XB_XCNT(j)]); sum += c; cnt += (c > 0u) ? 1u : 0u; mine = (j == x) ? c : mine; }
        if (sum == G) break;
        __builtin_amdgcn_s_sleep(1);
        if ((++sp & 255u) == 0u) { if (xb_ld(&bar[XB_TMO])) break; if (sp > XB_SPIN_CAP) { atomicAdd(&bar[XB_TMO], 1u); break; } }
    }
    nloc = mine > 0u ? mine : 1u; nx = cnt > 0u ? cnt : 1u;
}
__device__ __forceinline__ void xcd_barrier(const XcdBarrier& b) {
    asm volatile("s_waitcnt vmcnt(0)" ::: "memory");
    __syncthreads();
    if (threadIdx.x == 0) {
        unsigned* bar = b.bar;
        __builtin_amdgcn_s_waitcnt(0);
        unsigned nloc = b.st[0], nx = b.st[1];
        if (nloc == 0u) { xcd_barrier_complete(bar, b.x, nloc, nx); b.st[0] = nloc; b.st[1] = nx; }
        const unsigned old = xb_add(&bar[XB_XSUB(b.x)], 1u);
        const unsigned gen = old / nloc;
        if (old + 1u == (gen + 1u) * nloc) {
            __builtin_amdgcn_fence(__ATOMIC_RELEASE, "agent");
            asm volatile("s_waitcnt vmcnt(0)" ::: "memory");
            const unsigned og = xb_add(&bar[XB_TOP], 1u);
            const unsigned tg = og / nx;
            if (og + 1u == (tg + 1u) * nx) xb_add(&bar[XB_TOPGEN], 1u);
            else XB_SPIN(xb_ld(&bar[XB_TOPGEN]) == tg, bar);
            __builtin_amdgcn_fence(__ATOMIC_ACQUIRE, "agent");
            xb_add(&bar[XB_XGEN(b.x)], 1u);
            asm volatile("s_waitcnt vmcnt(0)" ::: "memory");
        } else {
            XB_SPIN(xb_ld(&bar[XB_XGEN(b.x)]) == gen, bar);
            __builtin_amdgcn_fence(__ATOMIC_ACQUIRE, "agent");
            asm volatile("s_waitcnt vmcnt(0)" ::: "memory");
        }
    }
    __syncthreads();
}

__device__ __forceinline__ float wave_sum(float v) {
#pragma unroll
    for (int o = 1; o < 64; o <<= 1) v += __shfl_xor(v, o);
    return v;
}
__device__ __forceinline__ void p0_transpose_item(const float* W, int sld, int sc0, int k0, bf16_t* WT, int dld, int drow0, int dk0, LAS float* scr, int lane) {
#pragma unroll 8
    for (int i = 0; i < 32; ++i) { const int kk = 2 * i + (lane >> 5); scr[kk * 33 + (lane & 31)] = W[(size_t)(k0 + kk) * sld + sc0 + (lane & 31)]; }
    LDS_WAIT(); asm volatile("" ::: "memory");
    const int c = lane & 7;
#pragma unroll
    for (int j = 0; j < 4; ++j) { const int n = (lane >> 3) + 8 * j; const LAS float* s = scr + (8 * c) * 33 + n;
        u32x4 o; o.x = cvtpk(s[0 * 33], s[1 * 33]); o.y = cvtpk(s[2 * 33], s[3 * 33]); o.z = cvtpk(s[4 * 33], s[5 * 33]); o.w = cvtpk(s[6 * 33], s[7 * 33]);
        *(GAS u32x4*)(WT + (size_t)(drow0 + n) * dld + dk0 + k0 + 8 * c) = o; }
    LDS_WAIT(); asm volatile("" ::: "memory");
}

struct Args { Ptrs p; int ph_lo, ph_hi, li, pad; };

__global__ void __launch_bounds__(NWAVES * 64, 2) skel_fwd(Args args) {
    extern __shared__ __attribute__((aligned(16))) unsigned char lds[];
    LAS unsigned char* const L = (LAS unsigned char*)lds;
    volatile LAS unsigned* const MISC = (volatile LAS unsigned*)(L + MISC_OFF);
    const int tid = threadIdx.x, lane = tid & 63, wave = __builtin_amdgcn_readfirstlane(tid >> 6);
    const int G = gridDim.x; const int bx = blockIdx.x; const int vcu = (G % 8 == 0) ? (bx % 8) * (G / 8) + bx / 8 : bx;
    const Ptrs& P = args.p; unsigned char* const ws = P.ws;
    gu32* const ctl = (gu32*)(ws + WS_CTL);
    for (int u = tid; u < (LDS_BYTES - LDSCTL_OFF) / 4; u += NWAVES * 64) ((LAS unsigned*)(L + LDSCTL_OFF))[u] = 0u;
    __syncthreads();
    XcdBarrier bar; bar.bar = (unsigned*)(ctl + CW_BAR); bar.x = 0; bar.st = nullptr;
    if (N_LAUNCHES == 1) bar = xcd_barrier_post((unsigned*)(ctl + CW_BAR), MISC + 8);
#define GRID_BAR() do { if (N_LAUNCHES == 1) xcd_barrier(bar); } while (0)
    const int lo = args.ph_lo, hi = args.ph_hi;
#define IN(k) (((MK_PHASE_MASK >> (k)) & 1) && lo <= (k) && (k) < hi)
#define BOTH(k) (IN(k) && IN((k) + 1))
    const int gw = vcu * NWAVES + wave, NGW = G * NWAVES;

    if (IN(0)) {
        LAS float* scr = (LAS float*)(L + RING_OFF + wave * 16384);
        bf16_t* const win_t = (bf16_t*)(ws + WS_WIN_T); bf16_t* const wcat_t = (bf16_t*)(ws + WS_WCAT_T); bf16_t* const wo_t = (bf16_t*)(ws + WS_WO_T);
        constexpr int I_IN = (D / 64) * (DIN / 32), I_SQ = (D / 64) * (D / 32), NITEMS = I_IN + 3 * I_SQ;
        for (int it = gw; it < NITEMS; it += NGW) {
            int r = it;
            if (r < I_IN) { const int kb = r / (DIN / 32), nb = r % (DIN / 32), n0 = 32 * nb; p0_transpose_item(P.w_in, DIN, win_src_col(n0 >> 8, n0 & 255), 64 * kb, win_t, D, n0, 0, scr, lane); continue; } r -= I_IN;
            const int kb = (r % I_SQ) / (D / 32), nb = (r % I_SQ) % (D / 32), which = r / I_SQ;
            if (which == 0) p0_transpose_item(P.w_pc, D, 32 * nb, 64 * kb, wcat_t, 2 * D, 32 * nb, 0, scr, lane);
            else if (which == 1) p0_transpose_item(P.w_pa, D, 32 * nb, 64 * kb, wcat_t, 2 * D, 32 * nb, D, scr, lane);
            else p0_transpose_item(P.w_out, D, 32 * nb, 64 * kb, wo_t, D, 32 * nb, 0, scr, lane);
        }
        { float* rc = (float*)(ws + WS_ROPE); float* rs = rc + SEQ * 32;
          for (int i = vcu * NWAVES * 64 + tid; i < SEQ * 32; i += G * NWAVES * 64) { const int pos = i >> 5, d = i & 31;
              const float inv = (float)pow(10000.0, -(double)d / 32.0); const float ang = (float)pos * inv;
              rc[i] = (float)cos((double)ang); rs[i] = (float)sin((double)ang); } }
        bf16_t* const XN = (bf16_t*)(ws + WS_XN);
        for (int m = gw; m < M; m += NGW) {
            const GAS f32x4* xr = (const GAS f32x4*)(P.x + (size_t)m * D) + lane; const GAS f32x4* gr = (const GAS f32x4*)P.g_pre + lane;
            f32x4 v[4]; float s = 0.f;
#pragma unroll
            for (int j = 0; j < 4; ++j) { v[j] = xr[64 * j]; s += (v[j].x * v[j].x + v[j].y * v[j].y) + (v[j].z * v[j].z + v[j].w * v[j].w); }
            const float rstd = 1.f / sqrtf(wave_sum(s) * (1.f / D) + RMS_EPS);
            GAS u32x2* o8 = (GAS u32x2*)(XN + (size_t)m * D) + lane;
#pragma unroll
            for (int j = 0; j < 4; ++j) { const f32x4 g = gr[64 * j]; u32x2 w; w.x = cvtpk(v[j].x * rstd * g.x, v[j].y * rstd * g.y); w.y = cvtpk(v[j].z * rstd * g.z, v[j].w * rstd * g.w); o8[64 * j] = w; }
        }
        if (BOTH(0)) { if (N_LAUNCHES == 1) { cg::this_grid().sync(); } GRID_BAR(); }
    }

    if (IN(1)) {
        pg8::Gemm g{(const bf16_t*)(ws + WS_XN), (const bf16_t*)(ws + WS_WIN_T), D, D, M, DIN, D, D / pg8::BK, 0l};
        pg8::StaticOrder S; S.init(M, DIN, G, bx);
        pg8::EpiIn E{ws};
        pg8::gemm_phase<pg8::EpiIn, pg8::StaticOrder, true>(L + RING_OFF, g, S, E);
        if (BOTH(1)) GRID_BAR();
    }

    if (IN(2)) {
        bf16_t* const Qb = (bf16_t*)(ws + WS_Q); const bf16_t* const KVb = (const bf16_t*)(ws + WS_KV); const bf16_t* const ZAb = (const bf16_t*)(ws + WS_ZA);
        for (int i = 0; i < 4; ++i) {
            const int uu = vcu * 4 + i; if (uu >= BATCH * NKV * 16) break;
            const int bkh = uu >> 4, j = uu & 15;
            att::attn_unit(bkh >> 1, bkh & 1, j, Qb, KVb, ZAb, P.sinks, (LAS char*)(L + RING_OFF));
        }
        { const bf16_t* const Ub = (const bf16_t*)(ws + WS_U); bf16_t* const Gb = (bf16_t*)(ws + WS_G);
          const int sub = tid >> 7, c8 = (tid & 127) * 8;
          f32x4 wa[3], wb[3];
#pragma unroll
          for (int k = 0; k < 3; ++k) { wa[k] = *(const GAS f32x4*)(P.w_conv + k * D + c8); wb[k] = *(const GAS f32x4*)(P.w_conv + k * D + c8 + 4); }
          for (int it = vcu * 4 + sub; it < M / 16; it += G * 4) {
              const int r0 = it * 16; const bool first = (r0 & (SEQ - 1)) == 0;
              u32x4 u2 = {0u, 0u, 0u, 0u}, u1 = {0u, 0u, 0u, 0u};
              if (!first) { u2 = *(const GAS u32x4*)(Ub + (size_t)(r0 - 2) * D + c8); u1 = *(const GAS u32x4*)(Ub + (size_t)(r0 - 1) * D + c8); }
#pragma unroll 4
              for (int rr = 0; rr < 16; ++rr) {
                  const size_t off = (size_t)(r0 + rr) * D + c8;
                  const u32x4 u0 = *(const GAS u32x4*)(Ub + off); const u32x4 gv = *(const GAS u32x4*)(Gb + off);
                  u32x4 w;
#define CONV2(X, KA, KB, CA, CB) w.X = cvtpk(bflo(gv.X) * (KA[0][CA] * bflo(u2.X) + KA[1][CA] * bflo(u1.X) + KA[2][CA] * bflo(u0.X)), bfhi(gv.X) * (KB[0][CB] * bfhi(u2.X) + KB[1][CB] * bfhi(u1.X) + KB[2][CB] * bfhi(u0.X)))
                  CONV2(x, wa, wa, 0, 1); CONV2(y, wa, wa, 2, 3); CONV2(z, wb, wb, 0, 1); CONV2(w, wb, wb, 2, 3);
#undef CONV2
                  *(GAS u32x4*)(Gb + off) = w; u2 = u1; u1 = u0;
              }
          } }
        if (BOTH(2)) GRID_BAR();
    }

    if (IN(3)) {
        pg8::Gemm g{(const bf16_t*)(ws + WS_G), (const bf16_t*)(ws + WS_WCAT_T), D, 2 * D, M, D, 2 * D, 16, (long)(WS_Q - WS_G) - 16l * pg8::BK * 2};
        pg8::StaticOrder S; S.init(M, D, G, bx);
        pg8::EpiMerge E{(const bf16_t*)(ws + WS_R), (const bf16_t*)(ws + WS_SB), (bf16_t*)(ws + WS_XN)};
        pg8::gemm_phase<pg8::EpiMerge, pg8::StaticOrder, true>(L + RING_OFF, g, S, E);
        if (BOTH(3)) GRID_BAR();
    }

    if (IN(4)) {
        pg8::Gemm g{(const bf16_t*)(ws + WS_XN), (const bf16_t*)(ws + WS_WO_T), D, D, M, D, D, D / pg8::BK, 0l};
        pg8::StaticOrder S; S.init(M, D, G, bx);
        pg8::EpiOutF32 E{P.out};
        pg8::gemm_phase<pg8::EpiOutF32, pg8::StaticOrder, true>(L + RING_OFF, g, S, E);
        if (BOTH(4)) GRID_BAR();
    }

    if (IN(5)) {
        for (int m = gw; m < M; m += NGW) {
            GAS f32x4* yr = (GAS f32x4*)(P.out + (size_t)m * D) + lane; const GAS f32x4* xr = (const GAS f32x4*)(P.x + (size_t)m * D) + lane; const GAS f32x4* gr = (const GAS f32x4*)P.g_post + lane;
            f32x4 v[4]; float s = 0.f;
#pragma unroll
            for (int j = 0; j < 4; ++j) { v[j] = yr[64 * j]; s += (v[j].x * v[j].x + v[j].y * v[j].y) + (v[j].z * v[j].z + v[j].w * v[j].w); }
            const float rstd = 1.f / sqrtf(wave_sum(s) * (1.f / D) + RMS_EPS);
#pragma unroll
            for (int j = 0; j < 4; ++j) yr[64 * j] = xr[64 * j] + v[j] * rstd * gr[64 * j];
        }
    }
#undef IN
#undef BOTH
#undef GRID_BAR
}

extern "C" void kernel_launch(void* const* d_in, const int* in_sizes, int n_in, void* d_out, int out_size, void* d_ws, size_t ws_size, hipStream_t stream) {
    static int grid = 0;
    if (grid == 0) {
        if (n_in != 9 || in_sizes[0] != M * D || out_size != M * D || ws_size < WS_END) { fprintf(stderr, "kernel_launch: unexpected shapes (n_in %d, in0 %d, out %d, ws %zu); nothing launched\n", n_in, n_in > 0 ? in_sizes[0] : -1, out_size, ws_size); grid = -1; return; }
        int dev = 0, cus = 0, per_cu = 0;
        if (hipGetDevice(&dev) != hipSuccess || hipDeviceGetAttribute(&cus, hipDeviceAttributeMultiprocessorCount, dev) != hipSuccess) { fprintf(stderr, "kernel_launch: device query failed\n"); grid = -1; return; }
        if (hipFuncSetAttribute((const void*)skel_fwd, hipFuncAttributeMaxDynamicSharedMemorySize, LDS_BYTES) != hipSuccess) { fprintf(stderr, "kernel_launch: hipFuncSetAttribute failed\n"); grid = -1; return; }
        if (hipOccupancyMaxActiveBlocksPerMultiprocessor(&per_cu, (const void*)skel_fwd, NWAVES * 64, LDS_BYTES) != hipSuccess || per_cu < 1) { fprintf(stderr, "kernel_launch: occupancy query says %d workgroups per CU\n", per_cu); (void)hipGetLastError(); per_cu = 1; }
        grid = cus * (per_cu < 1 ? 1 : 1);
        fprintf(stderr, "kernel_launch: %d CUs, occupancy query %d, grid %d\n", cus, per_cu, grid);
    }
    if (grid < 0) return;
    Ptrs p{};
    p.x = (const float*)d_in[0]; p.g_pre = (const float*)d_in[1]; p.g_post = (const float*)d_in[2]; p.w_in = (const float*)d_in[3]; p.w_conv = (const float*)d_in[4];
    p.sinks = (const float*)d_in[5]; p.w_pc = (const float*)d_in[6]; p.w_pa = (const float*)d_in[7]; p.w_out = (const float*)d_in[8]; p.out = (float*)d_out; p.ws = (unsigned char*)d_ws;
    if (hipMemsetAsync((char*)d_ws + WS_CTL, 0, CTL_ZERO_BYTES, stream) != hipSuccess) { fprintf(stderr, "kernel_launch: hipMemsetAsync failed\n"); return; }
    Args a{}; a.p = p;
    if (N_LAUNCHES == 1) {
        a.ph_lo = 0; a.ph_hi = PER_PHASE; a.li = 0;
        void* kargs[] = {&a};
        const hipError_t e = hipLaunchCooperativeKernel((const void*)skel_fwd, dim3(grid), dim3(NWAVES * 64), kargs, LDS_BYTES, stream);
        if (e != hipSuccess) fprintf(stderr, "kernel_launch: cooperative launch failed: %s (grid %d)\n", hipGetErrorString(e), grid);
    } else {
        for (int k = 0; k < PER_PHASE; ++k) {
            if ((MK_NAIVE_MASK >> k) & 1) {
                switch (k) {
                case 0: hipLaunchKernelGGL(nv::prep_weights, dim3(2048), dim3(256), 0, stream, p); hipLaunchKernelGGL(nv::prep_xn, dim3(M / 4), dim3(256), 0, stream, p); break;
                case 1: hipLaunchKernelGGL(nv::gemm1, dim3((M / 32) * NT1), dim3(256), 0, stream, p); break;
                case 2: hipLaunchKernelGGL(nv::conv, dim3((unsigned)((size_t)M * D / 256)), dim3(256), 0, stream, p); hipLaunchKernelGGL(nv::attn, dim3((unsigned)((size_t)M * NHEAD / 4)), dim3(256), 0, stream, p); break;
                case 3: hipLaunchKernelGGL(nv::gemm_merge, dim3((M / 32) * 32 / 4), dim3(256), 0, stream, p); break;
                case 4: hipLaunchKernelGGL(nv::gemm_out, dim3((M / 32) * 32 / 4), dim3(256), 0, stream, p); break;
                default: hipLaunchKernelGGL(nv::finalize, dim3(M / 4), dim3(256), 0, stream, p); break;
                }
            } else {
                a.ph_lo = k; a.ph_hi = k + 1; a.li = k;
                hipLaunchKernelGGL(skel_fwd, dim3(grid), dim3(NWAVES * 64), LDS_BYTES, stream, a);
            }
        }
    }
}
```

```cpp
#include <hip/hip_runtime.h>
#include <hip/hip_cooperative_groups.h>
#include <cstdio>
#include <cstdint>
namespace cg = cooperative_groups;

#ifndef MK_N_LAUNCHES
#define MK_N_LAUNCHES 1
#endif
#ifndef MK_NAIVE_MASK
#define MK_NAIVE_MASK 0
#endif

#ifndef MK_SHADOW
#define MK_SHADOW 0
#endif
#ifndef MK_PHASE_MASK
#define MK_PHASE_MASK 63
#endif

typedef unsigned short bf16_t;
typedef short bf16x8 __attribute__((ext_vector_type(8)));
typedef float f32x16 __attribute__((ext_vector_type(16)));
typedef float f32x4 __attribute__((ext_vector_type(4)));
typedef float f32x2 __attribute__((ext_vector_type(2)));
typedef unsigned u32x4 __attribute__((ext_vector_type(4)));
typedef unsigned u32x2 __attribute__((ext_vector_type(2)));
typedef __bf16 bf16x2_t __attribute__((ext_vector_type(2)));

constexpr int BATCH = 32, SEQ = 2048, D = 1024, M = BATCH * SEQ;
constexpr int NHEAD = 16, HD = 64, NKV = 2, GROUP = 8, WINDOW = 128;
constexpr int DIN = 8448, NT1 = DIN / 256;
constexpr int O_XC = 0, O_BG = 1024, O_CG = 2048, O_ZC = 3072, O_Q = 4096, O_K = 5120, O_V = 5248, O_ZA = 5376, O_GA = 6400, O_GB = 7424;
constexpr float RMS_EPS = 1e-6f;
constexpr float LOG2E = 1.4426950408889634f;
constexpr float QSCALE = 0.125f * LOG2E;

constexpr size_t MiB = 1u << 20;
constexpr size_t WS_CTL = 0, CTL_ZERO_BYTES = 1 * MiB;
constexpr size_t WS_WIN_T = 1 * MiB;
constexpr size_t WS_WCAT_T = 18 * MiB;
constexpr size_t WS_WO_T = 22 * MiB;
constexpr size_t WS_ROPE = 24 * MiB;
constexpr size_t WS_XCH = 25 * MiB;
constexpr size_t WS_XN = 32 * MiB;
constexpr size_t WS_U = 160 * MiB;
constexpr size_t WS_G = 288 * MiB;
constexpr size_t WS_Q = 416 * MiB;
constexpr size_t WS_ZA = 544 * MiB;
constexpr size_t WS_R = 672 * MiB;
constexpr size_t WS_SB = 800 * MiB;
constexpr size_t WS_KV = 928 * MiB;
constexpr size_t WS_END = 960 * MiB;
constexpr int CW_BAR = 4096;
constexpr int CW_SEAM = 16384;

__host__ __device__ __forceinline__ unsigned f2bf(float f) { unsigned u = __builtin_bit_cast(unsigned, f); return (u + 0x7fffu + ((u >> 16) & 1u)) >> 16; }
__host__ __device__ __forceinline__ float bf2f(unsigned b) { return __builtin_bit_cast(float, (b & 0xffffu) << 16); }
__device__ __forceinline__ unsigned cvtpk(float lo, float hi) { f32x2 v = {lo, hi}; bf16x2_t b = __builtin_convertvector(v, bf16x2_t); return __builtin_bit_cast(unsigned, b); }
__device__ __forceinline__ float bflo(unsigned w) { return __builtin_bit_cast(float, w << 16); }
__device__ __forceinline__ float bfhi(unsigned w) { return __builtin_bit_cast(float, w & 0xffff0000u); }

__host__ __device__ __forceinline__ int win_src_col(int pn, int j) {
    if (pn < 16) { const int c0 = 64 * pn; return j < 64 ? O_XC + c0 + j : j < 128 ? O_BG + c0 + (j - 64) : j < 192 ? O_CG + c0 + (j - 128) : O_ZC + c0 + (j - 192); }
    if (pn < 20) { const int hf = j >> 7, jj = j & 127, hh = jj >> 5, d = (jj & 31) + 32 * hf; return O_Q + (4 * (pn - 16) + hh) * 64 + d; }
    if (pn == 20) { const int hf = j >> 7, jj = j & 127;
        if (jj < 64) { const int hh = jj >> 5, d = (jj & 31) + 32 * hf; return O_K + hh * 64 + d; }
        return O_V + hf * 64 + (jj - 64); }
    if (pn < 25) return O_ZA + 256 * (pn - 21) + j;
    { const int c0 = 128 * (pn - 25); return j < 128 ? O_GA + c0 + j : O_GB + c0 + (j - 128); }
}

struct Ptrs {
    const float *x, *g_pre, *g_post, *w_in, *w_conv, *sinks, *w_pc, *w_pa, *w_out;
    float* out; unsigned char* ws;
};

__device__ __forceinline__ float sigmoidf_(float v) { return 1.f / (1.f + __expf(-v)); }

__device__ __forceinline__ void epi_pair(unsigned char* ws, int pn, int r, int j, float v0, float v1) {
    bf16_t* U = (bf16_t*)(ws + WS_U); bf16_t* G = (bf16_t*)(ws + WS_G); bf16_t* Q = (bf16_t*)(ws + WS_Q); bf16_t* ZA = (bf16_t*)(ws + WS_ZA);
    bf16_t* R = (bf16_t*)(ws + WS_R); bf16_t* SB = (bf16_t*)(ws + WS_SB); bf16_t* KV = (bf16_t*)(ws + WS_KV);
    const float* rc = (const float*)(ws + WS_ROPE); const float* rs = rc + SEQ * 32;
    if (pn < 16) {
        const int c0 = 64 * pn;
        if (j < 64) U[(size_t)r * D + c0 + j] = (bf16_t)f2bf(v1 * v0);
        else        G[(size_t)r * D + c0 + (j - 64)] = (bf16_t)f2bf(v1 * sigmoidf_(v1) * v0);
    } else if (pn < 20) {
        const int hh = j >> 5, d = j & 31, head = 4 * (pn - 16) + hh, pos = r & (SEQ - 1);
        const float c = rc[pos * 32 + d], s = rs[pos * 32 + d];
        Q[(size_t)r * D + head * 64 + d] = (bf16_t)f2bf((v0 * c - v1 * s) * QSCALE);
        Q[(size_t)r * D + head * 64 + 32 + d] = (bf16_t)f2bf((v1 * c + v0 * s) * QSCALE);
    } else if (pn == 20) {
        if (j < 64) { const int hh = j >> 5, d = j & 31, pos = r & (SEQ - 1); const float c = rc[pos * 32 + d], s = rs[pos * 32 + d];
            KV[(size_t)r * 256 + hh * 64 + d] = (bf16_t)f2bf(v0 * c - v1 * s); KV[(size_t)r * 256 + hh * 64 + 32 + d] = (bf16_t)f2bf(v1 * c + v0 * s); }
        else { KV[(size_t)r * 256 + 128 + (j - 64)] = (bf16_t)f2bf(v0); KV[(size_t)r * 256 + 192 + (j - 64)] = (bf16_t)f2bf(v1); }
    } else if (pn < 25) {
        const int c = 256 * (pn - 21) + j;
        ZA[(size_t)r * D + c] = (bf16_t)f2bf(v0 * sigmoidf_(v0)); ZA[(size_t)r * D + c + 128] = (bf16_t)f2bf(v1 * sigmoidf_(v1));
    } else {
        const int c = 128 * (pn - 25) + j;
        const float ga = fminf(fmaxf(v0, -60.f), 60.f), gb = fminf(fmaxf(v1, -60.f), 60.f);
        const float ea = __expf(-ga), eb = __expf(-gb);
        SB[(size_t)r * D + c] = (bf16_t)f2bf(1.f / (1.f + eb));
        R[(size_t)r * D + c] = (bf16_t)f2bf((1.f + eb) / (1.f + ea));
    }
}

namespace nv {
__global__ void prep_weights(Ptrs p) {
    const size_t tid = (size_t)blockIdx.x * blockDim.x + threadIdx.x, nth = (size_t)gridDim.x * blockDim.x;
    bf16_t* win_t = (bf16_t*)(p.ws + WS_WIN_T); bf16_t* wcat_t = (bf16_t*)(p.ws + WS_WCAT_T); bf16_t* wo_t = (bf16_t*)(p.ws + WS_WO_T);
    for (size_t i = tid; i < (size_t)DIN * D; i += nth) { const int n = (int)(i / D), k = (int)(i % D); win_t[i] = (bf16_t)f2bf(p.w_in[(size_t)k * DIN + win_src_col(n >> 8, n & 255)]); }
    for (size_t i = tid; i < (size_t)D * 2 * D; i += nth) { const int n = (int)(i / (2 * D)), k = (int)(i % (2 * D)); wcat_t[i] = (bf16_t)f2bf(k < D ? p.w_pc[(size_t)k * D + n] : p.w_pa[(size_t)(k - D) * D + n]); }
    for (size_t i = tid; i < (size_t)D * D; i += nth) { const int n = (int)(i / D), k = (int)(i % D); wo_t[i] = (bf16_t)f2bf(p.w_out[(size_t)k * D + n]); }
    float* rc = (float*)(p.ws + WS_ROPE); float* rs = rc + SEQ * 32;
    for (size_t i = tid; i < (size_t)SEQ * 32; i += nth) { const int pos = (int)(i / 32), d = (int)(i % 32);
        const float inv = (float)pow(10000.0, -(double)d / 32.0); const float ang = (float)pos * inv;
        rc[i] = (float)cos((double)ang); rs[i] = (float)sin((double)ang); }
}
__global__ void prep_xn(Ptrs p) {
    const int lane = threadIdx.x & 63; const int row = blockIdx.x * (blockDim.x >> 6) + (threadIdx.x >> 6);
    const f32x4* xr = (const f32x4*)(p.x + (size_t)row * D) + lane; const f32x4* gr = (const f32x4*)p.g_pre + lane;
    f32x4 v[4]; float s = 0.f;
#pragma unroll
    for (int j = 0; j < 4; ++j) { v[j] = xr[64 * j]; s += (v[j].x * v[j].x + v[j].y * v[j].y) + (v[j].z * v[j].z + v[j].w * v[j].w); }
#pragma unroll
    for (int o = 1; o < 64; o <<= 1) s += __shfl_xor(s, o);
    const float rstd = 1.f / sqrtf(s * (1.f / D) + RMS_EPS);
    unsigned long long* o8 = (unsigned long long*)((bf16_t*)(p.ws + WS_XN) + (size_t)row * D) + lane;
#pragma unroll
    for (int j = 0; j < 4; ++j) { const f32x4 g = gr[64 * j];
        const unsigned lo = f2bf(v[j].x * rstd * g.x) | (f2bf(v[j].y * rstd * g.y) << 16), hi = f2bf(v[j].z * rstd * g.z) | (f2bf(v[j].w * rstd * g.w) << 16);
        o8[64 * j] = (unsigned long long)lo | ((unsigned long long)hi << 32); }
}
__device__ __forceinline__ void tile32(const bf16_t* A, int lda, const bf16_t* Bt, int ldb, int K, int row0, int col0, f32x16& acc, int lane) {
    const int r = lane & 31, h = lane >> 5;
    const bf16_t* ap = A + (size_t)(row0 + r) * lda + 8 * h; const bf16_t* bp = Bt + (size_t)(col0 + r) * ldb + 8 * h;
    for (int k = 0; k < K; k += 16) { const bf16x8 a = *(const bf16x8*)(ap + k), b = *(const bf16x8*)(bp + k); acc = __builtin_amdgcn_mfma_f32_32x32x16_bf16(a, b, acc, 0, 0, 0); }
}
__device__ __forceinline__ int crow(int reg, int h) { return (reg & 3) + 8 * (reg >> 2) + 4 * h; }
__global__ void gemm1(Ptrs p) {
    const int lane = threadIdx.x & 63, w = threadIdx.x >> 6; const int pn = blockIdx.x % NT1, row0 = (blockIdx.x / NT1) * 32, j0 = 32 * w;
    const bf16_t* A = (const bf16_t*)(p.ws + WS_XN); const bf16_t* Bt = (const bf16_t*)(p.ws + WS_WIN_T);
    f32x16 a0 = {}, a1 = {};
    tile32(A, D, Bt, D, D, row0, pn * 256 + j0, a0, lane); tile32(A, D, Bt, D, D, row0, pn * 256 + 128 + j0, a1, lane);
    const int h = lane >> 5, c = lane & 31;
#pragma unroll
    for (int r = 0; r < 16; ++r) epi_pair(p.ws, pn, row0 + crow(r, h), j0 + c, a0[r], a1[r]);
}
__global__ void conv(Ptrs p) {
    const size_t i = (size_t)blockIdx.x * blockDim.x + threadIdx.x; const int r = (int)(i / D), c = (int)(i % D), t = r & (SEQ - 1);
    const bf16_t* U = (const bf16_t*)(p.ws + WS_U); bf16_t* G = (bf16_t*)(p.ws + WS_G);
    const float w0 = p.w_conv[c], w1 = p.w_conv[D + c], w2 = p.w_conv[2 * D + c];
    float y = w2 * bf2f(U[i]); if (t >= 1) y += w1 * bf2f(U[i - D]); if (t >= 2) y += w0 * bf2f(U[i - 2 * D]);
    G[i] = (bf16_t)f2bf(bf2f(G[i]) * y);
}
__global__ void attn(Ptrs p) {
    const int lane = threadIdx.x & 63; const size_t wv = (size_t)blockIdx.x * (blockDim.x >> 6) + (threadIdx.x >> 6);
    const int r = (int)(wv / NHEAD), h = (int)(wv % NHEAD), t = r & (SEQ - 1), kh = h / GROUP;
    bf16_t* Q = (bf16_t*)(p.ws + WS_Q); const bf16_t* KV = (const bf16_t*)(p.ws + WS_KV); const bf16_t* ZA = (const bf16_t*)(p.ws + WS_ZA);
    const float qd = bf2f(Q[(size_t)r * D + h * 64 + lane]);
    float l0 = 0.f, l1 = 0.f;
    for (int d = 0; d < 64; ++d) { const float q = __shfl(qd, d);
        if (t - lane >= 0) l0 += q * bf2f(KV[(size_t)(r - lane) * 256 + kh * 64 + d]);
        if (t - 64 - lane >= 0) l1 += q * bf2f(KV[(size_t)(r - 64 - lane) * 256 + kh * 64 + d]); }
    if (t - lane < 0) l0 = -INFINITY; if (t - 64 - lane < 0) l1 = -INFINITY;
    const float sk = p.sinks[h] * LOG2E;
    float m = fmaxf(fmaxf(l0, l1), sk);
#pragma unroll
    for (int o = 1; o < 64; o <<= 1) m = fmaxf(m, __shfl_xor(m, o));
    const float p0 = exp2f(l0 - m), p1 = exp2f(l1 - m);
    float s = p0 + p1;
#pragma unroll
    for (int o = 1; o < 64; o <<= 1) s += __shfl_xor(s, o);
    s += exp2f(sk - m);
    float o = 0.f;
    for (int kk = 0; kk < 64; ++kk) { const float a = __shfl(p0, kk), b = __shfl(p1, kk);
        if (t - kk >= 0) o += a * bf2f(KV[(size_t)(r - kk) * 256 + 128 + kh * 64 + lane]);
        if (t - 64 - kk >= 0) o += b * bf2f(KV[(size_t)(r - 64 - kk) * 256 + 128 + kh * 64 + lane]); }
    o /= s;
    Q[(size_t)r * D + h * 64 + lane] = (bf16_t)f2bf(bf2f(ZA[(size_t)r * D + h * 64 + lane]) * o);
}
__global__ void gemm_merge(Ptrs p) {
    const int lane = threadIdx.x & 63; const size_t wv = (size_t)blockIdx.x * (blockDim.x >> 6) + (threadIdx.x >> 6);
    const int row0 = (int)(wv / 32) * 32, col0 = (int)(wv % 32) * 32;
    const bf16_t* UA = (const bf16_t*)(p.ws + WS_G); const bf16_t* UB = (const bf16_t*)(p.ws + WS_Q); const bf16_t* Wc = (const bf16_t*)(p.ws + WS_WCAT_T);
    const bf16_t* R = (const bf16_t*)(p.ws + WS_R); const bf16_t* SB = (const bf16_t*)(p.ws + WS_SB); bf16_t* MG = (bf16_t*)(p.ws + WS_XN);
    f32x16 acc = {};
    tile32(UA, D, Wc, 2 * D, D, row0, col0, acc, lane);
    const int h = lane >> 5, c = col0 + (lane & 31);
#pragma unroll
    for (int r = 0; r < 16; ++r) acc[r] *= bf2f(R[(size_t)(row0 + crow(r, h)) * D + c]);
    tile32(UB, D, Wc + D, 2 * D, D, row0, col0, acc, lane);
#pragma unroll
    for (int r = 0; r < 16; ++r) { const size_t o = (size_t)(row0 + crow(r, h)) * D + c; MG[o] = (bf16_t)f2bf(acc[r] * bf2f(SB[o])); }
}
__global__ void gemm_out(Ptrs p) {
    const int lane = threadIdx.x & 63; const size_t wv = (size_t)blockIdx.x * (blockDim.x >> 6) + (threadIdx.x >> 6);
    const int row0 = (int)(wv / 32) * 32, col0 = (int)(wv % 32) * 32;
    f32x16 acc = {};
    tile32((const bf16_t*)(p.ws + WS_XN), D, (const bf16_t*)(p.ws + WS_WO_T), D, D, row0, col0, acc, lane);
    const int h = lane >> 5, c = col0 + (lane & 31);
#pragma unroll
    for (int r = 0; r < 16; ++r) p.out[(size_t)(row0 + crow(r, h)) * D + c] = acc[r];
}
__global__ void finalize(Ptrs p) {
    const int lane = threadIdx.x & 63; const int row = blockIdx.x * (blockDim.x >> 6) + (threadIdx.x >> 6);
    f32x4* yr = (f32x4*)(p.out + (size_t)row * D) + lane; const f32x4* xr = (const f32x4*)(p.x + (size_t)row * D) + lane; const f32x4* gr = (const f32x4*)p.g_post + lane;
    f32x4 v[4]; float s = 0.f;
#pragma unroll
    for (int j = 0; j < 4; ++j) { v[j] = yr[64 * j]; s += (v[j].x * v[j].x + v[j].y * v[j].y) + (v[j].z * v[j].z + v[j].w * v[j].w); }
#pragma unroll
    for (int o = 1; o < 64; o <<= 1) s += __shfl_xor(s, o);
    const float rstd = 1.f / sqrtf(s * (1.f / D) + RMS_EPS);
#pragma unroll
    for (int j = 0; j < 4; ++j) yr[64 * j] = xr[64 * j] + v[j] * rstd * gr[64 * j];
}
}


namespace pg8 {
#define PG8_LAS __attribute__((address_space(3)))
constexpr int BM = 256, BK = 64, HALF = 128, HTB = HALF * BK * 2  , STAGE_BYTES = 8 * HTB, NXCD = 8, WGM = 8;

__host__ __device__ __forceinline__ int lds_byte(int r, int c) { const int st = (r >> 4) * 2 + (c >> 5), rr = r & 15, cc = c & 31, ob = rr * 64 + cc * 2; return st * 1024 + (ob ^ (((ob >> 9) & 1) << 5)); }
__host__ __device__ __forceinline__ void stage_rc(int b, int& R, int& C) { const int st = b / 1024, sb = b % 1024, swz = sb ^ (((sb >> 9) & 1) << 5); R = (st >> 1) * 16 + swz / 64; C = (st & 1) * 32 + (swz % 64) / 2; }
__host__ __device__ __forceinline__ int perm32(int rho) { const int n = rho >> 4, i = rho & 15; return 8 * (i >> 2) + 4 * n + (i & 3); }

struct Unit { int pm, pn; };
struct Gemm { const bf16_t* A; const bf16_t* Bt; int lda, ldb, M, N, K; int ksplit; long adelta; };

struct StaticOrder {
    int nM, nN, nwg, G, c;
    __host__ __device__ void init(int M_, int N_, int G_, int c_) { nM = M_ / BM; nN = N_ / BM; nwg = nM * nN; G = G_; c = c_; }
    __host__ __device__ bool next(int i, Unit& u) const {
        const long L = (long)i * G + c; if (L >= nwg) return false;
        int wgid = (int)L; { const int q = nwg / NXCD, r = nwg % NXCD, xcd = wgid % NXCD, off = wgid / NXCD; wgid = (xcd < r ? xcd * (q + 1) : r * (q + 1) + (xcd - r) * q) + off; }
        const int nig = WGM * nN, gid = wgid / nig, fm = gid * WGM, gsz = (nM - fm) < WGM ? (nM - fm) : WGM;
        u.pm = fm + ((wgid % nig) % gsz); u.pn = (wgid % nig) / gsz; return true;
    }
};

template <class Epi, class Sched, bool ALIGN_EPI>
__device__ __forceinline__ void gemm_phase(PG8_LAS unsigned char* lds, const Gemm g, const Sched& S, const Epi& E) {
    const int tid = threadIdx.x, wid = __builtin_amdgcn_readfirstlane(tid >> 6), lane = tid & 63, wr = wid >> 2, wc = wid & 3, fr = lane & 15, fq = lane >> 4;
    const int nt = g.K / BK;
    unsigned voffA[2], voffB[2];
#pragma unroll
    for (int i = 0; i < 2; ++i) { int R, C; stage_rc(tid * 16 + i * 8192, R, C); const int Rb = Epi::PERM ? ((R & ~31) + perm32(R & 31)) : R;
        voffA[i] = (unsigned)(R * g.lda + C) * 2u; voffB[i] = (unsigned)(Rb * g.ldb + C) * 2u; }
    const size_t kstep = (size_t)(BK * 2);
    const size_t hstepA = (size_t)HALF * g.lda * 2, hstepB = (size_t)HALF * g.ldb * 2;
    const size_t tstepA = 2 * hstepA, tstepB = 2 * hstepB;
    const unsigned ldsw = (unsigned)wid * 1024u;
    const int aoff = lds_byte(wr * 64 + fr, fq * 8), boff = lds_byte(wc * 32 + fr, fq * 8);
#define PG8_SA(b, h) (((b) * 2 + (h)) * HTB)
#define PG8_SB(b, h) ((4 + (b) * 2 + (h)) * HTB)
#define PG8_STAGE(bufoff, gbase, voff) do { _Pragma("unroll") for (int _i = 0; _i < 2; ++_i) \
        __builtin_amdgcn_global_load_lds((const unsigned*)((const char*)(gbase) + (voff)[_i]), (PG8_LAS unsigned*)(lds + (bufoff) + ldsw + _i * 8192), 16, 0, 0); } while (0)
#define PG8_LDA(dst, b, h) do { _Pragma("unroll") for (int m = 0; m < 4; ++m) _Pragma("unroll") for (int k = 0; k < 2; ++k) dst[m][k] = *(const PG8_LAS bf16x8*)(lds + PG8_SA(b, h) + aoff + m * 2048 + k * 1024); } while (0)
#define PG8_LDB(dst, b, h) do { _Pragma("unroll") for (int n = 0; n < 2; ++n) _Pragma("unroll") for (int k = 0; k < 2; ++k) dst[n][k] = *(const PG8_LAS bf16x8*)(lds + PG8_SB(b, h) + boff + n * 2048 + k * 1024); } while (0)
#define PG8_MMA(ai, bj, At, Bt) do { __builtin_amdgcn_s_setprio(1); _Pragma("unroll") for (int m = 0; m < 4; ++m) _Pragma("unroll") for (int n = 0; n < 2; ++n) _Pragma("unroll") for (int k = 0; k < 2; ++k) \
        acc[ai][bj][m][n] = __builtin_amdgcn_mfma_f32_16x16x32_bf16(Bt[n][k], At[m][k], acc[ai][bj][m][n], 0, 0, 0); __builtin_amdgcn_s_setprio(0); } while (0)
#define PG8_WAIT_V(n) asm volatile("s_waitcnt vmcnt(" #n ")" ::: "memory")
#define PG8_WAIT_L(n) asm volatile("s_waitcnt lgkmcnt(" #n ")" ::: "memory")
#define PG8_BAR __builtin_amdgcn_s_barrier()
#define PG8_SCHED __builtin_amdgcn_sched_barrier(0)
    Unit cur, nxt; int ui = 0;
    if (!S.next(0, cur)) return;
    f32x4 acc[2][2][4][2];
#pragma unroll
    for (int a = 0; a < 2; ++a)
#pragma unroll
        for (int b = 0; b < 2; ++b)
#pragma unroll
            for (int m = 0; m < 4; ++m)
#pragma unroll
                for (int n = 0; n < 2; ++n) acc[a][b][m][n] = (f32x4){0.f, 0.f, 0.f, 0.f};
    bf16x8 At[4][2], B0[2][2], B1[2][2];
    const char* cA = (const char*)g.A + (size_t)cur.pm * tstepA; const char* cB = (const char*)g.Bt + (size_t)cur.pn * tstepB;
    PG8_STAGE(PG8_SB(0, 0), cB, voffB); PG8_STAGE(PG8_SB(0, 1), cB + hstepB, voffB); PG8_STAGE(PG8_SA(0, 0), cA, voffA); PG8_STAGE(PG8_SA(0, 1), cA + hstepA, voffA);
    if (wr == 1) PG8_BAR;
    PG8_WAIT_V(2); PG8_BAR;
    PG8_STAGE(PG8_SB(1, 0), cB + kstep, voffB); PG8_STAGE(PG8_SA(1, 0), cA + kstep, voffA); PG8_STAGE(PG8_SB(1, 1), cB + hstepB + kstep, voffB);
    PG8_WAIT_V(6); PG8_BAR;
    for (;;) {
        const bool has_next = S.next(ui + 1, nxt);
        const char* nA = has_next ? (const char*)g.A + (size_t)nxt.pm * tstepA : cA; const char* nB = has_next ? (const char*)g.Bt + (size_t)nxt.pn * tstepB : cB;
        for (int t = 0; t < nt; t += 2) {
            const bool last = (t == nt - 2);
            const char* a1 = cA + (size_t)(t + 1) * kstep + ((t + 1) >= g.ksplit ? g.adelta : 0l);
            const char* a2 = last ? nA : cA + (size_t)(t + 2) * kstep + ((t + 2) >= g.ksplit ? g.adelta : 0l);
            const char* b2 = last ? nB : cB + (size_t)(t + 2) * kstep;
            const char* a3 = a2 + kstep; const char* b3 = b2 + kstep;
            if constexpr (Epi::MID) { if (t == g.ksplit) { int fr_ = fr, fq_ = fq; asm volatile("" : "+v"(fr_), "+v"(fq_)); E.mid(acc, cur, wr, wc, fr_, fq_); } }
            PG8_LDB(B0, 0, 0); PG8_LDB(B1, 0, 1); PG8_SCHED; PG8_LDA(At, 0, 0); PG8_STAGE(PG8_SA(1, 1), a1 + hstepA, voffA);
            PG8_WAIT_V(8); PG8_WAIT_L(0); PG8_BAR; PG8_MMA(0, 0, At, B0); PG8_MMA(0, 1, At, B1); PG8_BAR; PG8_SCHED;
            PG8_LDA(At, 0, 1); PG8_STAGE(PG8_SB(0, 0), b2, voffB); PG8_STAGE(PG8_SB(0, 1), b2 + hstepB, voffB); PG8_STAGE(PG8_SA(0, 0), a2, voffA);
            PG8_WAIT_V(8); PG8_WAIT_L(0); PG8_BAR; PG8_MMA(1, 0, At, B0); PG8_MMA(1, 1, At, B1); PG8_BAR; PG8_SCHED;
            PG8_LDB(B0, 1, 0); PG8_LDB(B1, 1, 1); PG8_SCHED; PG8_LDA(At, 1, 0); PG8_STAGE(PG8_SA(0, 1), a2 + hstepA, voffA);
            PG8_WAIT_V(8); PG8_WAIT_L(0); PG8_BAR; PG8_MMA(0, 0, At, B0); PG8_MMA(0, 1, At, B1); PG8_BAR; PG8_SCHED;
            PG8_LDA(At, 1, 1); PG8_STAGE(PG8_SB(1, 0), b3, voffB); PG8_STAGE(PG8_SB(1, 1), b3 + hstepB, voffB); PG8_STAGE(PG8_SA(1, 0), a3, voffA);
            PG8_WAIT_V(8); PG8_WAIT_L(0); PG8_BAR; PG8_MMA(1, 0, At, B0); PG8_MMA(1, 1, At, B1); PG8_BAR; PG8_SCHED;
        }
        if constexpr (ALIGN_EPI) { if (wr == 0) PG8_BAR; }
        { int fr_ = fr, fq_ = fq; asm volatile("" : "+v"(fr_), "+v"(fq_)); E(acc, cur, wr, wc, fr_, fq_); }
        if (!has_next) break;
#pragma unroll
        for (int a = 0; a < 2; ++a)
#pragma unroll
            for (int b = 0; b < 2; ++b)
#pragma unroll
                for (int m = 0; m < 4; ++m)
#pragma unroll
                    for (int n = 0; n < 2; ++n) acc[a][b][m][n] = (f32x4){0.f, 0.f, 0.f, 0.f};
        cur = nxt; cA = nA; cB = nB; ++ui;
        if constexpr (ALIGN_EPI) { if (wr == 1) PG8_BAR; }
    }
    PG8_WAIT_V(0);
    if constexpr (!ALIGN_EPI) { if (wr == 0) PG8_BAR; }
    PG8_BAR;
#undef PG8_SA
#undef PG8_SB
#undef PG8_STAGE
#undef PG8_LDA
#undef PG8_LDB
#undef PG8_MMA
#undef PG8_WAIT_V
#undef PG8_WAIT_L
#undef PG8_BAR
#undef PG8_SCHED
}

__device__ __forceinline__ float silu_f(float v) { return v * __builtin_amdgcn_rcpf(1.f + __builtin_amdgcn_exp2f(-LOG2E * v)); }
__device__ __forceinline__ u32x4 pack8(const float (&v)[8]) { u32x4 w; w.x = cvtpk(v[0], v[1]); w.y = cvtpk(v[2], v[3]); w.z = cvtpk(v[4], v[5]); w.w = cvtpk(v[6], v[7]); return w; }

struct EpiIn {
    static constexpr bool PERM = true, MID = false;
    unsigned char* ws;
    __device__ __forceinline__ void mid(f32x4 (&)[2][2][4][2], const Unit&, int, int, int, int) const {}
    __device__ __forceinline__ void operator()(const f32x4 (&acc)[2][2][4][2], const Unit& u, int wr, int wc, int fr, int fq) const {
        const int pn = u.pn, row0 = u.pm * BM + wr * 64 + fr, j0 = wc * 32 + 8 * fq;
        bf16_t* const Ub = (bf16_t*)(ws + WS_U); bf16_t* const Gb = (bf16_t*)(ws + WS_G); bf16_t* const Qb = (bf16_t*)(ws + WS_Q); bf16_t* const ZAb = (bf16_t*)(ws + WS_ZA);
        bf16_t* const Rb = (bf16_t*)(ws + WS_R); bf16_t* const SBb = (bf16_t*)(ws + WS_SB); bf16_t* const KVb = (bf16_t*)(ws + WS_KV);
        const float* const rc = (const float*)(ws + WS_ROPE); const float* const rs = rc + SEQ * 32;
#pragma unroll
        for (int ai = 0; ai < 2; ++ai)
#pragma unroll
            for (int m = 0; m < 4; ++m) {
                const int row = row0 + ai * HALF + m * 16;
                float v0[8], v1[8], o0[8], o1[8];
#pragma unroll
                for (int e = 0; e < 4; ++e) { v0[e] = acc[ai][0][m][0][e]; v0[4 + e] = acc[ai][0][m][1][e]; v1[e] = acc[ai][1][m][0][e]; v1[4 + e] = acc[ai][1][m][1][e]; }
                if (pn < 16) {
                    if (wc < 2) {
#pragma unroll
                        for (int e = 0; e < 8; ++e) o0[e] = v1[e] * v0[e];
                        *(u32x4*)(Ub + (size_t)row * D + 64 * pn + j0) = pack8(o0);
                    } else {
#pragma unroll
                        for (int e = 0; e < 8; ++e) o0[e] = silu_f(v1[e]) * v0[e];
                        *(u32x4*)(Gb + (size_t)row * D + 64 * pn + (j0 - 64)) = pack8(o0);
                    }
                } else if (pn < 20 || (pn == 20 && wc < 2)) {
                    const int pos = row & (SEQ - 1), d0 = 8 * fq;
                    const f32x4 c0 = *(const f32x4*)(rc + pos * 32 + d0), c1 = *(const f32x4*)(rc + pos * 32 + d0 + 4), s0 = *(const f32x4*)(rs + pos * 32 + d0), s1 = *(const f32x4*)(rs + pos * 32 + d0 + 4);
                    const float sc = (pn < 20) ? QSCALE : 1.f;
#pragma unroll
                    for (int e = 0; e < 8; ++e) { const float c = e < 4 ? c0[e] : c1[e - 4], s = e < 4 ? s0[e] : s1[e - 4]; o0[e] = (v0[e] * c - v1[e] * s) * sc; o1[e] = (v1[e] * c + v0[e] * s) * sc; }
                    bf16_t* dst = (pn < 20) ? Qb + (size_t)row * D + (4 * (pn - 16) + wc) * 64 + d0 : KVb + (size_t)row * 256 + wc * 64 + d0;
                    *(u32x4*)dst = pack8(o0); *(u32x4*)(dst + 32) = pack8(o1);
                } else if (pn == 20) {
                    const int jj = 32 * (wc - 2) + 8 * fq;
                    *(u32x4*)(KVb + (size_t)row * 256 + 128 + jj) = pack8(v0); *(u32x4*)(KVb + (size_t)row * 256 + 192 + jj) = pack8(v1);
                } else if (pn < 25) {
#pragma unroll
                    for (int e = 0; e < 8; ++e) { o0[e] = silu_f(v0[e]); o1[e] = silu_f(v1[e]); }
                    bf16_t* dst = ZAb + (size_t)row * D + 256 * (pn - 21) + j0;
                    *(u32x4*)dst = pack8(o0); *(u32x4*)(dst + 128) = pack8(o1);
                } else {
#pragma unroll
                    for (int e = 0; e < 8; ++e) { const float ga = fminf(fmaxf(v0[e], -60.f), 60.f), gb = fminf(fmaxf(v1[e], -60.f), 60.f);
                        const float ea = __builtin_amdgcn_exp2f(-LOG2E * ga), eb = __builtin_amdgcn_exp2f(-LOG2E * gb);
                        o0[e] = __builtin_amdgcn_rcpf(1.f + eb); o1[e] = (1.f + eb) * __builtin_amdgcn_rcpf(1.f + ea); }
                    const size_t off = (size_t)row * D + 128 * (pn - 25) + j0;
                    *(u32x4*)(SBb + off) = pack8(o0); *(u32x4*)(Rb + off) = pack8(o1);
                }
            }
    }
};

struct EpiMerge {
    static constexpr bool PERM = true, MID = true;
    const bf16_t* R; const bf16_t* SB; bf16_t* MG;
    __device__ __forceinline__ void mid(f32x4 (&acc)[2][2][4][2], const Unit& u, int wr, int wc, int fr, int fq) const {
        const bf16_t* rp = R + (size_t)(u.pm * BM + wr * 64 + fr) * D + u.pn * BM + wc * 32 + 8 * fq;
#pragma unroll
        for (int ai = 0; ai < 2; ++ai)
#pragma unroll
            for (int m = 0; m < 4; ++m) {
#pragma unroll
                for (int bj = 0; bj < 2; ++bj) { const u32x4 w = *(const u32x4*)(rp + (size_t)(ai * HALF + m * 16) * D + bj * HALF);
                    acc[ai][bj][m][0] *= (f32x4){bflo(w.x), bfhi(w.x), bflo(w.y), bfhi(w.y)}; acc[ai][bj][m][1] *= (f32x4){bflo(w.z), bfhi(w.z), bflo(w.w), bfhi(w.w)}; }
                if (m & 1) asm volatile("" ::: "memory"); }
    }
    __device__ __forceinline__ void operator()(const f32x4 (&acc)[2][2][4][2], const Unit& u, int wr, int wc, int fr, int fq) const {
        const size_t base = (size_t)(u.pm * BM + wr * 64 + fr) * D + u.pn * BM + wc * 32 + 8 * fq;
#pragma unroll
        for (int ai = 0; ai < 2; ++ai)
#pragma unroll
            for (int m = 0; m < 4; ++m) {
#pragma unroll
                for (int bj = 0; bj < 2; ++bj) { const size_t off = base + (size_t)(ai * HALF + m * 16) * D + bj * HALF; const u32x4 w = *(const u32x4*)(SB + off);
                    const f32x4 a = acc[ai][bj][m][0] * (f32x4){bflo(w.x), bfhi(w.x), bflo(w.y), bfhi(w.y)}, b = acc[ai][bj][m][1] * (f32x4){bflo(w.z), bfhi(w.z), bflo(w.w), bfhi(w.w)};
                    u32x4 o; o.x = cvtpk(a[0], a[1]); o.y = cvtpk(a[2], a[3]); o.z = cvtpk(b[0], b[1]); o.w = cvtpk(b[2], b[3]); *(u32x4*)(MG + off) = o; }
                if (m & 1) asm volatile("" ::: "memory"); }
    }
};

struct EpiOutF32 {
    static constexpr bool PERM = false, MID = false;
    float* out;
    __device__ __forceinline__ void mid(f32x4 (&)[2][2][4][2], const Unit&, int, int, int, int) const {}
    __device__ __forceinline__ void operator()(const f32x4 (&acc)[2][2][4][2], const Unit& u, int wr, int wc, int fr, int fq) const {
        const int row0 = u.pm * BM + wr * 64 + fr, col0 = u.pn * BM + wc * 32 + 4 * fq;
#pragma unroll
        for (int ai = 0; ai < 2; ++ai)
#pragma unroll
            for (int m = 0; m < 4; ++m)
#pragma unroll
                for (int bj = 0; bj < 2; ++bj)
#pragma unroll
                    for (int n = 0; n < 2; ++n) *(f32x4*)(out + (size_t)(row0 + ai * HALF + m * 16) * D + col0 + bj * HALF + n * 16) = acc[ai][bj][m][n];
    }
};

template <bool STORE> struct EpiProbe {
    static constexpr bool PERM = true, MID = false;
    bf16_t* O;
    __device__ __forceinline__ void mid(f32x4 (&)[2][2][4][2], const Unit&, int, int, int, int) const {}
    __device__ __forceinline__ void operator()(const f32x4 (&acc)[2][2][4][2], const Unit& u, int wr, int wc, int fr, int fq) const {
#pragma unroll
        for (int ai = 0; ai < 2; ++ai)
#pragma unroll
            for (int m = 0; m < 4; ++m)
#pragma unroll
                for (int bj = 0; bj < 2; ++bj) {
                    if (STORE) { const f32x4 a = acc[ai][bj][m][0], b = acc[ai][bj][m][1]; u32x4 o; o.x = cvtpk(a[0], a[1]); o.y = cvtpk(a[2], a[3]); o.z = cvtpk(b[0], b[1]); o.w = cvtpk(b[2], b[3]);
                        *(u32x4*)(O + (size_t)(u.pm * BM + wr * 64 + fr + ai * HALF + m * 16) * 512 + (u.pn & 1) * 256 + wc * 32 + 8 * fq + bj * HALF) = o; }
                    else asm volatile("" :: "v"(acc[ai][bj][m][0]), "v"(acc[ai][bj][m][1]));
                }
    }
};
}

namespace att {
#define ATT_LAS __attribute__((address_space(3)))
typedef short v4i16_t __attribute__((ext_vector_type(4)));
typedef short s16x4 __attribute__((ext_vector_type(4)));
constexpr int KIMG = 0, VIMG = 32768, WSF = 65536, OST = WSF + 2048, LDS_BYTES = OST + 8 * 4096;
__device__ __forceinline__ int crow(int r, int hi) { return (r & 3) + 8 * (r >> 2) + 4 * hi; }
__device__ __forceinline__ void glds16(const void* gsrc, unsigned lds_dst) { unsigned keep;
    asm volatile("s_mov_b32 %0, m0\n\ts_mov_b32 m0, %2\n\ts_nop 0\n\tglobal_load_lds_dwordx4 %1, off\n\ts_mov_b32 m0, %0" : "=&s"(keep) : "v"(gsrc), "s"(lds_dst) : "memory"); }
__device__ __forceinline__ s16x4 vtr(const ATT_LAS char* p) { return __builtin_bit_cast(s16x4, __builtin_amdgcn_ds_read_tr16_b64_v4i16((ATT_LAS v4i16_t*)p)); }

template <bool LO, bool HI, bool KMIN> __device__ __forceinline__ void mask_tile(f32x16& p0, f32x16& p1, int kb, int qi, int hi, int kmin) {
    const float NEG = -INFINITY;
#pragma unroll
    for (int r = 0; r < 16; ++r) { const int k0 = kb + crow(r, hi), k1 = k0 + 32;
        bool ok0 = true, ok1 = true;
        if (LO) { ok0 = ok0 && (k0 > qi); ok1 = ok1 && (k1 > qi); }
        if (HI) { ok0 = ok0 && (k0 <= qi + 128); ok1 = ok1 && (k1 <= qi + 128); }
        if (KMIN) { ok0 = ok0 && (k0 >= kmin); ok1 = ok1 && (k1 >= kmin); }
        p0[r] = ok0 ? p0[r] : NEG; p1[r] = ok1 ? p1[r] : NEG; }
}
__device__ __forceinline__ float max16(const f32x16& p, float m) {
#pragma unroll
    for (int r = 0; r < 16; ++r) m = fmaxf(m, p[r]);
    return m;
}

__device__ __forceinline__ void attn_unit(int b, int kh, int j, bf16_t* Qb, const bf16_t* KVb, const bf16_t* ZAb, const float* sinks, ATT_LAS char* shm3) {
    const int tid = threadIdx.x, lane = tid & 63, r32 = lane & 31, hi = lane >> 5; const int wid = __builtin_amdgcn_readfirstlane(tid >> 6);
    const int head = kh * GROUP + wid; const long rowb = (long)b * SEQ; const int q0 = 128 * j;
    const unsigned lds0 = (unsigned)(uintptr_t)shm3;
#pragma unroll
    for (int T = 0; T < 4; ++T) {
        int kv0 = q0 - 128 + 64 * T; if (kv0 < 0) kv0 += 128;
        const bf16_t* ksrc = KVb + (size_t)(rowb + kv0 + lane) * 256 + kh * 64 + wid * 8;
        glds16(ksrc, (unsigned)__builtin_amdgcn_readfirstlane(lds0 + KIMG + T * 8192 + wid * 1024));
        const bf16_t* vsrc = KVb + (size_t)(rowb + kv0 + 16 * (wid & 3) + (lane >> 2)) * 256 + 128 + kh * 64 + (wid >> 2) * 32 + (lane & 3) * 8;
        glds16(vsrc, (unsigned)__builtin_amdgcn_readfirstlane(lds0 + VIMG + T * 8192 + wid * 1024));
    }
    ATT_LAS float* wsf = (ATT_LAS float*)(shm3 + WSF) + wid * 64;
    ATT_LAS bf16_t* stg = (ATT_LAS bf16_t*)(shm3 + OST) + wid * 2048;
    const float sink2 = sinks[head] * LOG2E;
    const int kmin = (j == 0) ? 128 : 0;
    asm volatile("s_waitcnt vmcnt(0)\n\ts_barrier" ::: "memory");
    for (int i = 0; i < 4; ++i) {
        const int T0 = i >> 1; const int qi = 32 * i + r32;
        const bf16_t* qrow = Qb + (size_t)(rowb + q0 + qi) * D + head * 64;
        bf16x8 qr[4];
#pragma unroll
        for (int d0 = 0; d0 < 4; ++d0) qr[d0] = *(const bf16x8*)(qrow + d0 * 16 + hi * 8);
        f32x16 s0[3], s1[3];
#pragma unroll
        for (int tt = 0; tt < 3; ++tt) {
            const ATT_LAS char* kb = shm3 + KIMG + (T0 + tt) * 8192 + hi * 1024 + r32 * 16;
            f32x16 a = {}, c = {};
#pragma unroll
            for (int d0 = 0; d0 < 4; ++d0) { const bf16x8 k0 = *(const ATT_LAS bf16x8*)(kb + d0 * 2048), k1 = *(const ATT_LAS bf16x8*)(kb + d0 * 2048 + 512);
                a = __builtin_amdgcn_mfma_f32_32x32x16_bf16(k0, qr[d0], a, 0, 0, 0); c = __builtin_amdgcn_mfma_f32_32x32x16_bf16(k1, qr[d0], c, 0, 0, 0); }
            s0[tt] = a; s1[tt] = c;
        }
        if (kmin) { mask_tile<true, true, true>(s0[0], s1[0], 64 * T0 + 0, qi, hi, kmin); mask_tile<true, true, true>(s0[1], s1[1], 64 * T0 + 64, qi, hi, kmin); mask_tile<true, true, true>(s0[2], s1[2], 64 * T0 + 128, qi, hi, kmin); }
        else { mask_tile<true, false, false>(s0[0], s1[0], 64 * T0, qi, hi, 0); mask_tile<false, true, false>(s0[2], s1[2], 64 * T0 + 128, qi, hi, 0); }
        float mx = sink2;
#pragma unroll
        for (int tt = 0; tt < 3; ++tt) { mx = max16(s0[tt], mx); mx = max16(s1[tt], mx); }
        { auto rr = __builtin_amdgcn_permlane32_swap(__float_as_uint(mx), __float_as_uint(mx), false, false); mx = fmaxf(__uint_as_float(rr[0]), __uint_as_float(rr[1])); }
        float l = 0.f;
#pragma unroll
        for (int tt = 0; tt < 3; ++tt)
#pragma unroll
            for (int r = 0; r < 16; ++r) { s0[tt][r] = __builtin_amdgcn_exp2f(s0[tt][r] - mx); s1[tt][r] = __builtin_amdgcn_exp2f(s1[tt][r] - mx); l += s0[tt][r] + s1[tt][r]; }
        { auto rr = __builtin_amdgcn_permlane32_swap(__float_as_uint(l), __float_as_uint(l), false, false); l = __uint_as_float(rr[0]) + __uint_as_float(rr[1]); }
        l += __builtin_amdgcn_exp2f(sink2 - mx);
        f32x16 o[2]; o[0] = f32x16{}; o[1] = f32x16{};
#pragma unroll
        for (int tt = 0; tt < 3; ++tt) {
            u32x4 pw[4];
            pw[0] = (u32x4){cvtpk(s0[tt][0], s0[tt][1]), cvtpk(s0[tt][2], s0[tt][3]), cvtpk(s0[tt][4], s0[tt][5]), cvtpk(s0[tt][6], s0[tt][7])};
            pw[1] = (u32x4){cvtpk(s0[tt][8], s0[tt][9]), cvtpk(s0[tt][10], s0[tt][11]), cvtpk(s0[tt][12], s0[tt][13]), cvtpk(s0[tt][14], s0[tt][15])};
            pw[2] = (u32x4){cvtpk(s1[tt][0], s1[tt][1]), cvtpk(s1[tt][2], s1[tt][3]), cvtpk(s1[tt][4], s1[tt][5]), cvtpk(s1[tt][6], s1[tt][7])};
            pw[3] = (u32x4){cvtpk(s1[tt][8], s1[tt][9]), cvtpk(s1[tt][10], s1[tt][11]), cvtpk(s1[tt][12], s1[tt][13]), cvtpk(s1[tt][14], s1[tt][15])};
            const ATT_LAS char* vp = shm3 + VIMG + (T0 + tt) * 8192 + ((lane >> 4) & 1) * 32 + (lane & 3) * 8 + (4 * hi + ((lane & 15) >> 2)) * 64;
#pragma unroll
            for (int d0 = 0; d0 < 2; ++d0)
#pragma unroll
                for (int ks = 0; ks < 4; ++ks) { const s16x4 lo = vtr(vp + d0 * 4096 + ks * 1024), hh = vtr(vp + d0 * 4096 + ks * 1024 + 512);
                    const bf16x8 vf = (bf16x8){lo[0], lo[1], lo[2], lo[3], hh[0], hh[1], hh[2], hh[3]};
                    o[d0] = __builtin_amdgcn_mfma_f32_32x32x16_bf16(__builtin_bit_cast(bf16x8, pw[ks]), vf, o[d0], 0, 0, 0); }
        }
        if (hi == 0) wsf[r32] = l;
        asm volatile("s_waitcnt lgkmcnt(0)" ::: "memory");
#pragma unroll
        for (int r = 0; r < 16; ++r) { const int orow = crow(r, hi); const float rl = __builtin_amdgcn_rcpf(wsf[orow]);
            stg[orow * 64 + r32] = (bf16_t)f2bf(o[0][r] * rl); stg[orow * 64 + 32 + r32] = (bf16_t)f2bf(o[1][r] * rl); }
        asm volatile("s_waitcnt lgkmcnt(0)" ::: "memory");
#pragma unroll
        for (int it = 0; it < 4; ++it) { const int row = it * 8 + (lane >> 3), ch = lane & 7;
            const u32x4 ov = *(const ATT_LAS u32x4*)(stg + row * 64 + ch * 8);
            const size_t goff = (size_t)(rowb + q0 + 32 * i + row) * D + head * 64 + ch * 8;
            const u32x4 zv = *(const u32x4*)(ZAb + goff);
            u32x4 w; w.x = cvtpk(bflo(ov.x) * bflo(zv.x), bfhi(ov.x) * bfhi(zv.x)); w.y = cvtpk(bflo(ov.y) * bflo(zv.y), bfhi(ov.y) * bfhi(zv.y));
            w.z = cvtpk(bflo(ov.z) * bflo(zv.z), bfhi(ov.z) * bfhi(zv.z)); w.w = cvtpk(bflo(ov.w) * bflo(zv.w), bfhi(ov.w) * bfhi(zv.w));
            *(u32x4*)(Qb + goff) = w; }
        asm volatile("s_waitcnt lgkmcnt(0)" ::: "memory");
    }
    asm volatile("s_waitcnt lgkmcnt(0)\n\ts_barrier" ::: "memory");
}
}

constexpr int NWAVES = 8;
constexpr int N_LAUNCHES = MK_N_LAUNCHES;
constexpr int PER_PHASE = 6;
constexpr int RING_OFF = 0, RING_BYTES = 131072;
constexpr int LDSCTL_OFF = RING_BYTES, MISC_OFF = LDSCTL_OFF + 320;
constexpr int LDS_BYTES = 147456;
static_assert(att::LDS_BYTES <= RING_BYTES, "attention scratch fits the ring region");

#define GAS __attribute__((address_space(1)))
#define LAS __attribute__((address_space(3)))
typedef GAS unsigned gu32;
#define RLX_AGENT __ATOMIC_RELAXED, __HIP_MEMORY_SCOPE_AGENT
#define LDS_WAIT() asm volatile("s_waitcnt lgkmcnt(0)" ::: "memory")
#define VM_WAIT() asm volatile("s_waitcnt vmcnt(0)" ::: "memory")

#define XB_TMO      128
#define XB_XCNT(j)  (256  + 64 * (j))
#define XB_XSUB(j)  (1280 + 64 * (j))
#define XB_XGEN(j)  (2304 + 64 * (j))
#define XB_TOP      3328
#define XB_TOPGEN   3392
#define XCD_BAR_WORDS 3456
#define XB_SPIN_CAP (1u << 18)
__device__ __forceinline__ unsigned xb_ld(unsigned* p)              { return __hip_atomic_load(p, __ATOMIC_RELAXED, __HIP_MEMORY_SCOPE_AGENT); }
__device__ __forceinline__ unsigned xb_add(unsigned* p, unsigned v) { return __hip_atomic_fetch_add(p, v, __ATOMIC_RELAXED, __HIP_MEMORY_SCOPE_AGENT); }
__device__ __forceinline__ unsigned xb_xcc_id() { return (unsigned)__builtin_amdgcn_s_getreg((3 << 11) | 20) & 0xFu; }
#define XB_SPIN(cond, bar) do { unsigned _sp = 0; while (cond) { __builtin_amdgcn_s_sleep(1); \
    if ((++_sp & 255u) == 0u) { if (xb_ld(&(bar)[XB_TMO])) break; if (_sp > XB_SPIN_CAP) { atomicAdd(&(bar)[XB_TMO], 1u); break; } } } } while (0)
struct XcdBarrier { unsigned* bar; unsigned x; volatile LAS unsigned* st; };
__device__ __forceinline__ XcdBarrier xcd_barrier_post(unsigned* bar, volatile LAS unsigned* st) {
    XcdBarrier b; b.bar = bar; b.x = xb_xcc_id(); b.st = st;
    if (threadIdx.x == 0) (void)xb_add(&bar[XB_XCNT(b.x)], 1u);
    return b;
}
__device__ __forceinline__ void xcd_barrier_complete(unsigned* bar, unsigned x, unsigned& nloc, unsigned& nx) {
    const unsigned G = gridDim.x * gridDim.y * gridDim.z;
    unsigned sum, cnt, mine, sp = 0u;
    for (;;) {
        sum = 0u; cnt = 0u; mine = 0u;
#pragma unroll
        for (unsigned j = 0; j < 16; ++j) { const unsigned c = xb_ld(&bar[XB_XCNT(j)]); sum += c; cnt += (c > 0u) ? 1u : 0u; mine = (j == x) ? c : mine; }
        if (sum == G) break;
        __builtin_amdgcn_s_sleep(1);
        if ((++sp & 255u) == 0u) { if (xb_ld(&bar[XB_TMO])) break; if (sp > XB_SPIN_CAP) { atomicAdd(&bar[XB_TMO], 1u); break; } }
    }
    nloc = mine > 0u ? mine : 1u; nx = cnt > 0u ? cnt : 1u;
}
__device__ __forceinline__ void xcd_barrier(const XcdBarrier& b) {
    asm volatile("s_waitcnt vmcnt(0)" ::: "memory");
    __syncthreads();
    if (threadIdx.x == 0) {
        unsigned* bar = b.bar;
        __builtin_amdgcn_s_waitcnt(0);
        unsigned nloc = b.st[0], nx = b.st[1];
        if (nloc == 0u) { xcd_barrier_complete(bar, b.x, nloc, nx); b.st[0] = nloc; b.st[1] = nx; }
        const unsigned old = xb_add(&bar[XB_XSUB(b.x)], 1u);
        const unsigned gen = old / nloc;
        if (old + 1u == (gen + 1u) * nloc) {
            __builtin_amdgcn_fence(__ATOMIC_RELEASE, "agent");
            asm volatile("s_waitcnt vmcnt(0)" ::: "memory");
            const unsigned og = xb_add(&bar[XB_TOP], 1u);
            const unsigned tg = og / nx;
            if (og + 1u == (tg + 1u) * nx) xb_add(&bar[XB_TOPGEN], 1u);
            else XB_SPIN(xb_ld(&bar[XB_TOPGEN]) == tg, bar);
            __builtin_amdgcn_fence(__ATOMIC_ACQUIRE, "agent");
            xb_add(&bar[XB_XGEN(b.x)], 1u);
            asm volatile("s_waitcnt vmcnt(0)" ::: "memory");
        } else {
            XB_SPIN(xb_ld(&bar[XB_XGEN(b.x)]) == gen, bar);
            __builtin_amdgcn_fence(__ATOMIC_ACQUIRE, "agent");
            asm volatile("s_waitcnt vmcnt(0)" ::: "memory");
        }
    }
    __syncthreads();
}

__device__ __forceinline__ float wave_sum(float v) {
#pragma unroll
    for (int o = 1; o < 64; o <<= 1) v += __shfl_xor(v, o);
    return v;
}
__device__ __forceinline__ void p0_transpose_item(const float* W, int sld, int sc0, int k0, bf16_t* WT, int dld, int drow0, int dk0, LAS float* scr, int lane) {
#pragma unroll 8
    for (int i = 0; i < 32; ++i) { const int kk = 2 * i + (lane >> 5); scr[kk * 33 + (lane & 31)] = W[(size_t)(k0 + kk) * sld + sc0 + (lane & 31)]; }
    LDS_WAIT(); asm volatile("" ::: "memory");
    const int c = lane & 7;
#pragma unroll
    for (int j = 0; j < 4; ++j) { const int n = (lane >> 3) + 8 * j; const LAS float* s = scr + (8 * c) * 33 + n;
        u32x4 o; o.x = cvtpk(s[0 * 33], s[1 * 33]); o.y = cvtpk(s[2 * 33], s[3 * 33]); o.z = cvtpk(s[4 * 33], s[5 * 33]); o.w = cvtpk(s[6 * 33], s[7 * 33]);
        *(GAS u32x4*)(WT + (size_t)(drow0 + n) * dld + dk0 + k0 + 8 * c) = o; }
    LDS_WAIT(); asm volatile("" ::: "memory");
}

struct Args { Ptrs p; int ph_lo, ph_hi, li, pad; };

__global__ void __launch_bounds__(NWAVES * 64, 2) skel_fwd(Args args) {
    extern __shared__ __attribute__((aligned(16))) unsigned char lds[];
    LAS unsigned char* const L = (LAS unsigned char*)lds;
    volatile LAS unsigned* const MISC = (volatile LAS unsigned*)(L + MISC_OFF);
    const int tid = threadIdx.x, lane = tid & 63, wave = __builtin_amdgcn_readfirstlane(tid >> 6);
    const int G = gridDim.x; const int bx = blockIdx.x; const int vcu = (G % 8 == 0) ? (bx % 8) * (G / 8) + bx / 8 : bx;
    const Ptrs& P = args.p; unsigned char* const ws = P.ws;
    gu32* const ctl = (gu32*)(ws + WS_CTL);
    for (int u = tid; u < (LDS_BYTES - LDSCTL_OFF) / 4; u += NWAVES * 64) ((LAS unsigned*)(L + LDSCTL_OFF))[u] = 0u;
    __syncthreads();
    XcdBarrier bar; bar.bar = (unsigned*)(ctl + CW_BAR); bar.x = 0; bar.st = nullptr;
    if (N_LAUNCHES == 1) bar = xcd_barrier_post((unsigned*)(ctl + CW_BAR), MISC + 8);
#define GRID_BAR() do { if (N_LAUNCHES == 1) xcd_barrier(bar); } while (0)
    const int lo = args.ph_lo, hi = args.ph_hi;
#define IN(k) (((MK_PHASE_MASK >> (k)) & 1) && lo <= (k) && (k) < hi)
#define BOTH(k) (IN(k) && IN((k) + 1))
    const int gw = vcu * NWAVES + wave, NGW = G * NWAVES;

    if (IN(0)) {
        LAS float* scr = (LAS float*)(L + RING_OFF + wave * 16384);
        bf16_t* const win_t = (bf16_t*)(ws + WS_WIN_T); bf16_t* const wcat_t = (bf16_t*)(ws + WS_WCAT_T); bf16_t* const wo_t = (bf16_t*)(ws + WS_WO_T);
        constexpr int I_IN = (D / 64) * (DIN / 32), I_SQ = (D / 64) * (D / 32), NITEMS = I_IN + 3 * I_SQ;
        for (int it = gw; it < NITEMS; it += NGW) {
            int r = it;
            if (r < I_IN) { const int kb = r / (DIN / 32), nb = r % (DIN / 32), n0 = 32 * nb; p0_transpose_item(P.w_in, DIN, win_src_col(n0 >> 8, n0 & 255), 64 * kb, win_t, D, n0, 0, scr, lane); continue; } r -= I_IN;
            const int kb = (r % I_SQ) / (D / 32), nb = (r % I_SQ) % (D / 32), which = r / I_SQ;
            if (which == 0) p0_transpose_item(P.w_pc, D, 32 * nb, 64 * kb, wcat_t, 2 * D, 32 * nb, 0, scr, lane);
            else if (which == 1) p0_transpose_item(P.w_pa, D, 32 * nb, 64 * kb, wcat_t, 2 * D, 32 * nb, D, scr, lane);
            else p0_transpose_item(P.w_out, D, 32 * nb, 64 * kb, wo_t, D, 32 * nb, 0, scr, lane);
        }
        { float* rc = (float*)(ws + WS_ROPE); float* rs = rc + SEQ * 32;
          for (int i = vcu * NWAVES * 64 + tid; i < SEQ * 32; i += G * NWAVES * 64) { const int pos = i >> 5, d = i & 31;
              const float inv = (float)pow(10000.0, -(double)d / 32.0); const float ang = (float)pos * inv;
              rc[i] = (float)cos((double)ang); rs[i] = (float)sin((double)ang); } }
        bf16_t* const XN = (bf16_t*)(ws + WS_XN);
        for (int m = gw; m < M; m += NGW) {
            const GAS f32x4* xr = (const GAS f32x4*)(P.x + (size_t)m * D) + lane; const GAS f32x4* gr = (const GAS f32x4*)P.g_pre + lane;
            f32x4 v[4]; float s = 0.f;
#pragma unroll
            for (int j = 0; j < 4; ++j) { v[j] = xr[64 * j]; s += (v[j].x * v[j].x + v[j].y * v[j].y) + (v[j].z * v[j].z + v[j].w * v[j].w); }
            const float rstd = 1.f / sqrtf(wave_sum(s) * (1.f / D) + RMS_EPS);
            GAS u32x2* o8 = (GAS u32x2*)(XN + (size_t)m * D) + lane;
#pragma unroll
            for (int j = 0; j < 4; ++j) { const f32x4 g = gr[64 * j]; u32x2 w; w.x = cvtpk(v[j].x * rstd * g.x, v[j].y * rstd * g.y); w.y = cvtpk(v[j].z * rstd * g.z, v[j].w * rstd * g.w); o8[64 * j] = w; }
        }
        if (BOTH(0)) GRID_BAR();
    }


#if MK_SHADOW == 1 || MK_SHADOW == 2 || MK_SHADOW == 3
    if (IN(1)) {
        pg8::Gemm g{(const bf16_t*)(ws + WS_XN), (const bf16_t*)(ws + WS_WIN_T), D, D, M, DIN, D, D / pg8::BK, 0l};
        pg8::StaticOrder S; S.init(M, DIN, G, bx);
#if MK_SHADOW == 3
        pg8::EpiIn E{ws}; pg8::gemm_phase<pg8::EpiIn, pg8::StaticOrder, true>(L + RING_OFF, g, S, E);
#else
        pg8::EpiProbe<MK_SHADOW == 2> E{(bf16_t*)P.out}; pg8::gemm_phase<pg8::EpiProbe<MK_SHADOW == 2>, pg8::StaticOrder, true>(L + RING_OFF, g, S, E);
#endif
        GRID_BAR();
    }
#endif
    if (IN(1)) {
        pg8::Gemm g{(const bf16_t*)(ws + WS_XN), (const bf16_t*)(ws + WS_WIN_T), D, D, M, DIN, D, D / pg8::BK, 0l};
        pg8::StaticOrder S; S.init(M, DIN, G, bx);
        pg8::EpiIn E{ws};
        pg8::gemm_phase<pg8::EpiIn, pg8::StaticOrder, true>(L + RING_OFF, g, S, E);
        if (BOTH(1)) GRID_BAR();
    }

    if (IN(2)) {
        bf16_t* const Qb = (bf16_t*)(ws + WS_Q); const bf16_t* const KVb = (const bf16_t*)(ws + WS_KV); const bf16_t* const ZAb = (const bf16_t*)(ws + WS_ZA);
        for (int i = 0; i < 4; ++i) {
            const int uu = vcu * 4 + i; if (uu >= BATCH * NKV * 16) break;
            const int bkh = uu >> 4, j = uu & 15;
            att::attn_unit(bkh >> 1, bkh & 1, j, Qb, KVb, ZAb, P.sinks, (LAS char*)(L + RING_OFF));
        }
        { const bf16_t* const Ub = (const bf16_t*)(ws + WS_U); bf16_t* const Gb = (bf16_t*)(ws + WS_G);
          const int sub = tid >> 7, c8 = (tid & 127) * 8;
          f32x4 wa[3], wb[3];
#pragma unroll
          for (int k = 0; k < 3; ++k) { wa[k] = *(const GAS f32x4*)(P.w_conv + k * D + c8); wb[k] = *(const GAS f32x4*)(P.w_conv + k * D + c8 + 4); }
          for (int it = vcu * 4 + sub; it < M / 16; it += G * 4) {
              const int r0 = it * 16; const bool first = (r0 & (SEQ - 1)) == 0;
              u32x4 u2 = {0u, 0u, 0u, 0u}, u1 = {0u, 0u, 0u, 0u};
              if (!first) { u2 = *(const GAS u32x4*)(Ub + (size_t)(r0 - 2) * D + c8); u1 = *(const GAS u32x4*)(Ub + (size_t)(r0 - 1) * D + c8); }
#pragma unroll 4
              for (int rr = 0; rr < 16; ++rr) {
                  const size_t off = (size_t)(r0 + rr) * D + c8;
                  const u32x4 u0 = *(const GAS u32x4*)(Ub + off); const u32x4 gv = *(const GAS u32x4*)(Gb + off);
                  u32x4 w;
#define CONV2(X, KA, KB, CA, CB) w.X = cvtpk(bflo(gv.X) * (KA[0][CA] * bflo(u2.X) + KA[1][CA] * bflo(u1.X) + KA[2][CA] * bflo(u0.X)), bfhi(gv.X) * (KB[0][CB] * bfhi(u2.X) + KB[1][CB] * bfhi(u1.X) + KB[2][CB] * bfhi(u0.X)))
                  CONV2(x, wa, wa, 0, 1); CONV2(y, wa, wa, 2, 3); CONV2(z, wb, wb, 0, 1); CONV2(w, wb, wb, 2, 3);
#undef CONV2
                  *(GAS u32x4*)(Gb + off) = w; u2 = u1; u1 = u0;
              }
          } }
        if (BOTH(2)) GRID_BAR();
    }

    if (IN(3)) {
        pg8::Gemm g{(const bf16_t*)(ws + WS_G), (const bf16_t*)(ws + WS_WCAT_T), D, 2 * D, M, D, 2 * D, 16, (long)(WS_Q - WS_G) - 16l * pg8::BK * 2};
        pg8::StaticOrder S; S.init(M, D, G, bx);
        pg8::EpiMerge E{(const bf16_t*)(ws + WS_R), (const bf16_t*)(ws + WS_SB), (bf16_t*)(ws + WS_XN)};
        pg8::gemm_phase<pg8::EpiMerge, pg8::StaticOrder, true>(L + RING_OFF, g, S, E);
        if (BOTH(3)) GRID_BAR();
    }

    if (IN(4)) {
        pg8::Gemm g{(const bf16_t*)(ws + WS_XN), (const bf16_t*)(ws + WS_WO_T), D, D, M, D, D, D / pg8::BK, 0l};
        pg8::StaticOrder S; S.init(M, D, G, bx);
        pg8::EpiOutF32 E{P.out};
        pg8::gemm_phase<pg8::EpiOutF32, pg8::StaticOrder, true>(L + RING_OFF, g, S, E);
        if (BOTH(4)) GRID_BAR();
    }

    if (IN(5)) {
        for (int m = gw; m < M; m += NGW) {
            GAS f32x4* yr = (GAS f32x4*)(P.out + (size_t)m * D) + lane; const GAS f32x4* xr = (const GAS f32x4*)(P.x + (size_t)m * D) + lane; const GAS f32x4* gr = (const GAS f32x4*)P.g_post + lane;
            f32x4 v[4]; float s = 0.f;
#pragma unroll
            for (int j = 0; j < 4; ++j) { v[j] = yr[64 * j]; s += (v[j].x * v[j].x + v[j].y * v[j].y) + (v[j].z * v[j].z + v[j].w * v[j].w); }
            const float rstd = 1.f / sqrtf(wave_sum(s) * (1.f / D) + RMS_EPS);
#pragma unroll
            for (int j = 0; j < 4; ++j) yr[64 * j] = xr[64 * j] + v[j] * rstd * gr[64 * j];
        }
    }
#undef IN
#undef BOTH
#undef GRID_BAR
}

extern "C" void kernel_launch(void* const* d_in, const int* in_sizes, int n_in, void* d_out, int out_size, void* d_ws, size_t ws_size, hipStream_t stream) {
    static int grid = 0;
    if (grid == 0) {
        if (n_in != 9 || in_sizes[0] != M * D || out_size != M * D || ws_size < WS_END) { fprintf(stderr, "kernel_launch: unexpected shapes (n_in %d, in0 %d, out %d, ws %zu); nothing launched\n", n_in, n_in > 0 ? in_sizes[0] : -1, out_size, ws_size); grid = -1; return; }
        int dev = 0, cus = 0, per_cu = 0;
        if (hipGetDevice(&dev) != hipSuccess || hipDeviceGetAttribute(&cus, hipDeviceAttributeMultiprocessorCount, dev) != hipSuccess) { fprintf(stderr, "kernel_launch: device query failed\n"); grid = -1; return; }
        if (hipFuncSetAttribute((const void*)skel_fwd, hipFuncAttributeMaxDynamicSharedMemorySize, LDS_BYTES) != hipSuccess) { fprintf(stderr, "kernel_launch: hipFuncSetAttribute failed\n"); grid = -1; return; }
        if (hipOccupancyMaxActiveBlocksPerMultiprocessor(&per_cu, (const void*)skel_fwd, NWAVES * 64, LDS_BYTES) != hipSuccess || per_cu < 1) { fprintf(stderr, "kernel_launch: occupancy query says %d workgroups per CU\n", per_cu); (void)hipGetLastError(); per_cu = 1; }
        grid = cus * (per_cu < 1 ? 1 : 1);
        fprintf(stderr, "kernel_launch: %d CUs, occupancy query %d, grid %d\n", cus, per_cu, grid);
    }
    if (grid < 0) return;
    Ptrs p{};
    p.x = (const float*)d_in[0]; p.g_pre = (const float*)d_in[1]; p.g_post = (const float*)d_in[2]; p.w_in = (const float*)d_in[3]; p.w_conv = (const float*)d_in[4];
    p.sinks = (const float*)d_in[5]; p.w_pc = (const float*)d_in[6]; p.w_pa = (const float*)d_in[7]; p.w_out = (const float*)d_in[8]; p.out = (float*)d_out; p.ws = (unsigned char*)d_ws;
    if (hipMemsetAsync((char*)d_ws + WS_CTL, 0, CTL_ZERO_BYTES, stream) != hipSuccess) { fprintf(stderr, "kernel_launch: hipMemsetAsync failed\n"); return; }
    Args a{}; a.p = p;
    if (N_LAUNCHES == 1) {
        a.ph_lo = 0; a.ph_hi = PER_PHASE; a.li = 0;
        void* kargs[] = {&a};
        const hipError_t e = hipLaunchCooperativeKernel((const void*)skel_fwd, dim3(grid), dim3(NWAVES * 64), kargs, LDS_BYTES, stream);
        if (e != hipSuccess) fprintf(stderr, "kernel_launch: cooperative launch failed: %s (grid %d)\n", hipGetErrorString(e), grid);
    } else {
        for (int k = 0; k < PER_PHASE; ++k) {
            if ((MK_NAIVE_MASK >> k) & 1) {
                switch (k) {
                case 0: hipLaunchKernelGGL(nv::prep_weights, dim3(2048), dim3(256), 0, stream, p); hipLaunchKernelGGL(nv::prep_xn, dim3(M / 4), dim3(256), 0, stream, p); break;
                case 1: hipLaunchKernelGGL(nv::gemm1, dim3((M / 32) * NT1), dim3(256), 0, stream, p); break;
                case 2: hipLaunchKernelGGL(nv::conv, dim3((unsigned)((size_t)M * D / 256)), dim3(256), 0, stream, p); hipLaunchKernelGGL(nv::attn, dim3((unsigned)((size_t)M * NHEAD / 4)), dim3(256), 0, stream, p); break;
                case 3: hipLaunchKernelGGL(nv::gemm_merge, dim3((M / 32) * 32 / 4), dim3(256), 0, stream, p); break;
                case 4: hipLaunchKernelGGL(nv::gemm_out, dim3((M / 32) * 32 / 4), dim3(256), 0, stream, p); break;
                default: hipLaunchKernelGGL(nv::finalize, dim3(M / 4), dim3(256), 0, stream, p); break;
                }
            } else {
                a.ph_lo = k; a.ph_hi = k + 1; a.li = k;
                hipLaunchKernelGGL(skel_fwd, dim3(grid), dim3(NWAVES * 64), LDS_BYTES, stream, a);
            }
        }
    }
}
```
